# Optimizing an MI355X kernel written in HIP

```python
import jax, jax.numpy as jnp
from jax import lax
import numpy as np

D_MODEL = 1024
BATCH = 16
SEQ = 2048
DEPTH = 1

D_MIX = D_MODEL
W_POOL = D_MIX // 2
W_CONV = D_MIX - W_POOL
POOL_WINDOWS = (2, 4, 8, 16)
N_POOL_GROUPS = len(POOL_WINDOWS)
POOL_GC = W_POOL // N_POOL_GROUPS
CONV_WIDTH = 31
N_CONV_HEADS = 8
D_IN = W_POOL * 2 + W_CONV * 3
RMS_EPS = 1e-6
LN_EPS = 1e-5

kernel_name = "hybrid_pool_conformer_gated_layer"


def _rmsnorm(x, g):
    xf = x.astype(jnp.float32)
    y = xf * lax.rsqrt(jnp.mean(xf * xf, axis=-1, keepdims=True) + RMS_EPS)
    return (y * g.astype(jnp.float32)).astype(x.dtype)


def _layernorm(x, g, b):
    xf = x.astype(jnp.float32)
    mu = jnp.mean(xf, axis=-1, keepdims=True)
    var = jnp.mean(jnp.square(xf - mu), axis=-1, keepdims=True)
    y = (xf - mu) * lax.rsqrt(var + LN_EPS)
    return (y * g.astype(jnp.float32) + b.astype(jnp.float32)).astype(x.dtype)


def _causal_window_mean(u, window):
    S = u.shape[1]
    cs = jnp.cumsum(u.astype(jnp.float32), axis=1)
    cs = jnp.concatenate([jnp.zeros_like(cs[:, :1]), cs], axis=1)
    t = jnp.arange(S)
    hi = t + 1
    lo = jnp.maximum(hi - window, 0)
    sums = cs[:, hi] - cs[:, lo]
    cnt = (hi - lo).astype(jnp.float32)[None, :, None]
    return (sums / cnt).astype(u.dtype)


def _pool_mixer(u, pool_w, pool_b, pool_scale):
    B, S, _ = u.shape
    ug = u.reshape(B, S, N_POOL_GROUPS, POOL_GC)
    pooled = jnp.stack(
        [_causal_window_mean(ug[:, :, gi], w) for gi, w in enumerate(POOL_WINDOWS)],
        axis=2)
    d = pooled - ug
    z = jnp.einsum('bsgc,gcd->bsgd', d, pool_w) + pool_b
    return z.reshape(B, S, W_POOL) * pool_scale


def _conformer_conv(v, g, conv_dw, conv_b, ln_g, ln_b, pw_w, pw_b):
    h = v * jax.nn.sigmoid(g)
    C = h.shape[-1]
    h = lax.conv_general_dilated(
        h, conv_dw[:, None, :].astype(h.dtype),
        window_strides=(1,),
        padding=[(CONV_WIDTH - 1, 0)],
        dimension_numbers=('NWC', 'WIO', 'NWC'),
        feature_group_count=C) + conv_b
    h = _layernorm(h, ln_g, ln_b)
    h = jax.nn.silu(h)
    return jnp.einsum('bsc,cd->bsd', h, pw_w) + pw_b


def setup_inputs(seed: int = 0) -> dict:
    key = jax.random.key(seed)
    ks = jax.random.split(key, 16)
    f32 = jnp.float32
    x = jax.random.normal(ks[0], (BATCH, SEQ, D_MODEL), f32)
    norm_g = 1.0 + 0.02 * jax.random.normal(ks[1], (D_MODEL,), f32)
    w_in = jax.random.normal(ks[2], (D_MODEL, D_IN), f32) * D_MODEL ** -0.5
    pool_w = jax.random.normal(ks[3], (N_POOL_GROUPS, POOL_GC, POOL_GC), f32) * POOL_GC ** -0.5
    pool_b = 0.02 * jax.random.normal(ks[4], (N_POOL_GROUPS, POOL_GC), f32)
    pool_scale = 0.5 + 0.05 * jax.random.normal(ks[5], (W_POOL,), f32)
    conv_dw = jax.random.normal(ks[6], (CONV_WIDTH, W_CONV), f32) * CONV_WIDTH ** -0.5
    conv_b = 0.02 * jax.random.normal(ks[7], (W_CONV,), f32)
    ln_g = 1.0 + 0.02 * jax.random.normal(ks[8], (W_CONV,), f32)
    ln_b = 0.02 * jax.random.normal(ks[9], (W_CONV,), f32)
    pw_w = jax.random.normal(ks[10], (W_CONV, W_CONV), f32) * W_CONV ** -0.5
    pw_b = 0.02 * jax.random.normal(ks[11], (W_CONV,), f32)
    w_out = jax.random.normal(ks[12], (D_MIX, D_MODEL), f32) * D_MIX ** -0.5
    final_g = 1.0 + 0.02 * jax.random.normal(ks[13], (D_MODEL,), f32)
    return {"x": x, "norm_g": norm_g, "w_in": w_in,
            "pool_w": pool_w, "pool_b": pool_b, "pool_scale": pool_scale,
            "conv_dw": conv_dw, "conv_b": conv_b, "ln_g": ln_g, "ln_b": ln_b,
            "pw_w": pw_w, "pw_b": pw_b, "w_out": w_out, "final_g": final_g}


def reference(x, norm_g, w_in, pool_w, pool_b, pool_scale, conv_dw, conv_b,
              ln_g, ln_b, pw_w, pw_b, w_out, final_g):
    h = x
    for _ in range(DEPTH):
        hn = _rmsnorm(h, norm_g)
        proj = jnp.einsum('bsd,de->bse', hn, w_in)
        o = 0
        a_val = proj[..., o:o + W_POOL]; o += W_POOL
        a_gate = proj[..., o:o + W_POOL]; o += W_POOL
        b_val = proj[..., o:o + W_CONV]; o += W_CONV
        b_glu = proj[..., o:o + W_CONV]; o += W_CONV
        b_gate = proj[..., o:o + W_CONV]
        y_a = _pool_mixer(a_val, pool_w, pool_b, pool_scale) * jax.nn.silu(a_gate)
        y_b = _conformer_conv(b_val, b_glu, conv_dw, conv_b, ln_g, ln_b, pw_w, pw_b) * jax.nn.silu(b_gate)
        y = jnp.concatenate([y_a, y_b], axis=-1)
        h = h + jnp.einsum('bse,ed->bsd', y, w_out)
    return _rmsnorm(h, final_g)
```

```cpp
#include <hip/hip_runtime.h>
#include <hip/hip_cooperative_groups.h>
#include <cstdio>
#include <cstdint>
namespace cg = cooperative_groups;
namespace pg8 {
#define PG8_LAS __attribute__((address_space(3)))
typedef unsigned short bf16_t;
typedef short bf16x8 __attribute__((ext_vector_type(8)));
typedef float f32x4 __attribute__((ext_vector_type(4)));
typedef unsigned u32x4 __attribute__((ext_vector_type(4)));
constexpr int BM = 256, BK = 64, HALF = 128, HTB = HALF * BK * 2  , STAGE_BYTES = 8 * HTB, NXCD = 8, WGM = 8;

__host__ __device__ __forceinline__ int lds_byte(int r, int c) { const int st = (r >> 4) * 2 + (c >> 5), rr = r & 15, cc = c & 31, ob = rr * 64 + cc * 2; return st * 1024 + (ob ^ (((ob >> 9) & 1) << 5)); }
__host__ __device__ __forceinline__ void stage_rc(int b, int& R, int& C) { const int st = b / 1024, sb = b % 1024, swz = sb ^ (((sb >> 9) & 1) << 5); R = (st >> 1) * 16 + swz / 64; C = (st & 1) * 32 + (swz % 64) / 2; }
__host__ __device__ __forceinline__ int perm32(int rho) { const int n = rho >> 4, i = rho & 15; return 8 * (i >> 2) + 4 * n + (i & 3); }

struct Unit { int pm, pn; };
struct Gemm { const bf16_t* A; const bf16_t* Bt; int M, N, K; };

struct StaticOrder {
    int nM, nN, nwg, G, c;
    __host__ __device__ void init(int M, int N, int G_, int c_) { nM = M / BM; nN = N / BM; nwg = nM * nN; G = G_; c = c_; }
    __host__ __device__ bool next(int i, Unit& u) const {
        const long L = (long)i * G + c; if (L >= nwg) return false;
        int wgid = (int)L; { const int q = nwg / NXCD, r = nwg % NXCD, xcd = wgid % NXCD, off = wgid / NXCD; wgid = (xcd < r ? xcd * (q + 1) : r * (q + 1) + (xcd - r) * q) + off; }
        const int nig = WGM * nN, gid = wgid / nig, fm = gid * WGM, gsz = (nM - fm) < WGM ? (nM - fm) : WGM;
        u.pm = fm + ((wgid % nig) % gsz); u.pn = (wgid % nig) / gsz; return true;
    }
    __device__ __forceinline__ void a_ready(const Unit&) const {}
    __device__ __forceinline__ void done(const Unit&) const {}
};
__device__ __forceinline__ unsigned cvt_pk_bf16(float lo, float hi) { unsigned r; asm volatile("v_cvt_pk_bf16_f32 %0, %1, %2" : "=v"(r) : "v"(lo), "v"(hi)); return r; }
typedef float f32x2 __attribute__((ext_vector_type(2)));

__device__ __forceinline__ float sigm(float v) { return __builtin_amdgcn_rcpf(1.0f + __expf(-v)); }
__device__ __forceinline__ float silu(float v) { return v * sigm(v); }
struct EpiProj {
    static constexpr bool PERM = true, AFTER_DRAIN = false;
    bf16_t* P;
    __device__ __forceinline__ void operator()(const f32x4 (&acc)[2][2][4][2], const Unit& u, int wr, int wc, int fr, int fq) const {
        const int row0 = u.pm * BM + wr * 64 + fr; const int pn = u.pn;
        if (pn >= 4 && pn < 8) {
            const int col0 = 1024 + 128 * (pn - 4) + wc * 32 + 8 * fq;
#pragma unroll
            for (int ai = 0; ai < 2; ++ai)
#pragma unroll
                for (int m = 0; m < 4; ++m) { bf16_t* rowp = P + (size_t)(row0 + ai * HALF + m * 16) * 2048 + col0;
                    const f32x4 v0 = acc[ai][0][m][0], v1 = acc[ai][0][m][1], g0 = acc[ai][1][m][0], g1 = acc[ai][1][m][1];
                    u32x4 w; w.x = cvt_pk_bf16(v0[0] * sigm(g0[0]), v0[1] * sigm(g0[1])); w.y = cvt_pk_bf16(v0[2] * sigm(g0[2]), v0[3] * sigm(g0[3]));
                    w.z = cvt_pk_bf16(v1[0] * sigm(g1[0]), v1[1] * sigm(g1[1])); w.w = cvt_pk_bf16(v1[2] * sigm(g1[2]), v1[3] * sigm(g1[3]));
                    *(u32x4*)rowp = w; }
        } else {
            const int colbase = pn < 4 ? 256 * pn : 1536 + 256 * (pn - 8); const bool act = pn >= 2;
            const int col0 = colbase + wc * 32 + 8 * fq;
#pragma unroll
            for (int ai = 0; ai < 2; ++ai)
#pragma unroll
                for (int m = 0; m < 4; ++m) { bf16_t* rowp = P + (size_t)(row0 + ai * HALF + m * 16) * 2048 + col0;
#pragma unroll
                    for (int bj = 0; bj < 2; ++bj) { f32x4 v0 = acc[ai][bj][m][0], v1 = acc[ai][bj][m][1];
                        if (act) {
#pragma unroll
                            for (int j = 0; j < 4; ++j) { v0[j] = silu(v0[j]); v1[j] = silu(v1[j]); } }
                        u32x4 w; w.x = cvt_pk_bf16(v0[0], v0[1]); w.y = cvt_pk_bf16(v0[2], v0[3]); w.z = cvt_pk_bf16(v1[0], v1[1]); w.w = cvt_pk_bf16(v1[2], v1[3]);
                        *(u32x4*)(rowp + bj * HALF) = w; } }
        }
    }
};
__device__ __forceinline__ float bf_lo(unsigned w) { return __uint_as_float(w << 16); }
__device__ __forceinline__ float bf_hi(unsigned w) { return __uint_as_float(w & 0xffff0000u); }
struct EpiPw {
    static constexpr bool PERM = true, AFTER_DRAIN = false;
    const bf16_t* P; bf16_t* Y; const float* bias;
    __device__ __forceinline__ void operator()(const f32x4 (&acc)[2][2][4][2], const Unit& u, int wr, int wc, int fr, int fq) const {
        const int row0 = u.pm * BM + wr * 64 + fr; const int col0 = u.pn * BM + wc * 32 + 8 * fq;
        f32x4 bv[2][2];
#pragma unroll
        for (int bj = 0; bj < 2; ++bj)
#pragma unroll
            for (int n = 0; n < 2; ++n) bv[bj][n] = *(const f32x4*)(bias + col0 + bj * HALF + 4 * n);
#pragma unroll
        for (int ai = 0; ai < 2; ++ai)
#pragma unroll
            for (int m = 0; m < 4; ++m) { const size_t row = (size_t)(row0 + ai * HALF + m * 16);
#pragma unroll
                for (int bj = 0; bj < 2; ++bj) { const u32x4 gt = *(const u32x4*)(P + row * 2048 + 1536 + col0 + bj * HALF);
                    const f32x4 v0 = acc[ai][bj][m][0] + bv[bj][0], v1 = acc[ai][bj][m][1] + bv[bj][1];
                    u32x4 w; w.x = cvt_pk_bf16(v0[0] * bf_lo(gt.x), v0[1] * bf_hi(gt.x)); w.y = cvt_pk_bf16(v0[2] * bf_lo(gt.y), v0[3] * bf_hi(gt.y));
                    w.z = cvt_pk_bf16(v1[0] * bf_lo(gt.z), v1[1] * bf_hi(gt.z)); w.w = cvt_pk_bf16(v1[2] * bf_lo(gt.w), v1[3] * bf_hi(gt.w));
                    *(u32x4*)(Y + row * 1024 + 512 + col0 + bj * HALF) = w; } }
    }
};
struct EpiOut {
    static constexpr bool PERM = false, AFTER_DRAIN = false;
    const float* x; float* out; float* part;
    __device__ __forceinline__ void operator()(const f32x4 (&acc)[2][2][4][2], const Unit& u, int wr, int wc, int fr, int fq) const {
        const int row0 = u.pm * BM + wr * 64 + fr, col0 = u.pn * BM + wc * 32 + 4 * fq;
#pragma unroll
        for (int ai = 0; ai < 2; ++ai)
#pragma unroll
            for (int m = 0; m < 4; ++m) { const int row = row0 + ai * HALF + m * 16; const size_t off = (size_t)row * 1024 + col0; float ss = 0.f;
#pragma unroll
                for (int bj = 0; bj < 2; ++bj)
#pragma unroll
                    for (int n = 0; n < 2; ++n) { const f32x4 xv = *(const f32x4*)(x + off + bj * HALF + n * 16); const f32x4 o = xv + acc[ai][bj][m][n];
                        *(f32x4*)(out + off + bj * HALF + n * 16) = o; ss += (o[0] * o[0] + o[1] * o[1]) + (o[2] * o[2] + o[3] * o[3]); }
                ss += __shfl_xor(ss, 16); ss += __shfl_xor(ss, 32);
                if (fq == 0) part[(size_t)row * 16 + u.pn * 4 + wc] = ss;
                asm volatile("" ::: "memory"); }
    }
};
template <class Epi, class Sched, bool ALIGN_EPI = false, bool SP2 = false>
__device__ __forceinline__ void gemm_phase(PG8_LAS unsigned char* lds, const Gemm g, const Sched& S, const Epi& E) {
    const int tid = threadIdx.x, wid = __builtin_amdgcn_readfirstlane(tid >> 6), lane = tid & 63, wr = wid >> 2, wc = wid & 3, fr = lane & 15, fq = lane >> 4;
    const int K = g.K, nt = K / BK;
    unsigned voffA[2], voffB[2];
#pragma unroll
    for (int i = 0; i < 2; ++i) { int R, C; stage_rc(tid * 16 + i * 8192, R, C); const int Rb = Epi::PERM ? ((R & ~31) + perm32(R & 31)) : R;
        voffA[i] = (unsigned)(R * K + C) * 2u; voffB[i] = (unsigned)(Rb * K + C) * 2u; }
    const size_t kstep = (size_t)(BK * 2);
    const size_t hstep = (size_t)HALF * K * 2;
    const size_t tstep = 2 * hstep;
    const unsigned ldsw = (unsigned)wid * 1024u;
    const int aoff = lds_byte(wr * 64 + fr, fq * 8), boff = lds_byte(wc * 32 + fr, fq * 8);
#define PG8_SA(b, h) (((b) * 2 + (h)) * HTB)
#define PG8_SB(b, h) ((4 + (b) * 2 + (h)) * HTB)
#define PG8_STAGE(bufoff, gbase, voff) do { _Pragma("unroll") for (int _i = 0; _i < 2; ++_i) \
        __builtin_amdgcn_global_load_lds((const unsigned*)((const char*)(gbase) + (voff)[_i]), (PG8_LAS unsigned*)(lds + (bufoff) + ldsw + _i * 8192), 16, 0, 0); } while (0)
#define PG8_LDA(dst, b, h) do { _Pragma("unroll") for (int m = 0; m < 4; ++m) _Pragma("unroll") for (int k = 0; k < 2; ++k) dst[m][k] = *(const PG8_LAS bf16x8*)(lds + PG8_SA(b, h) + aoff + m * 2048 + k * 1024); } while (0)
#define PG8_LDB(dst, b, h) do { _Pragma("unroll") for (int n = 0; n < 2; ++n) _Pragma("unroll") for (int k = 0; k < 2; ++k) dst[n][k] = *(const PG8_LAS bf16x8*)(lds + PG8_SB(b, h) + boff + n * 2048 + k * 1024); } while (0)
#define PG8_MMA(ai, bj, At, Bt) do { __builtin_amdgcn_s_setprio(1); _Pragma("unroll") for (int m = 0; m < 4; ++m) _Pragma("unroll") for (int n = 0; n < 2; ++n) _Pragma("unroll") for (int k = 0; k < 2; ++k) \
        acc[ai][bj][m][n] = __builtin_amdgcn_mfma_f32_16x16x32_bf16(Bt[n][k], At[m][k], acc[ai][bj][m][n], 0, 0, 0); __builtin_amdgcn_s_setprio(0); } while (0)
#define PG8_WAIT_V(n) asm volatile("s_waitcnt vmcnt(" #n ")" ::: "memory")
#define PG8_WAIT_L(n) asm volatile("s_waitcnt lgkmcnt(" #n ")" ::: "memory")
#define PG8_BAR __builtin_amdgcn_s_barrier()
#define PG8_SCHED __builtin_amdgcn_sched_barrier(0)
    Unit cur, nxt; int ui = 0;
    if (!S.next(0, cur)) return;
    f32x4 acc[2][2][4][2];
#pragma unroll
    for (int a = 0; a < 2; ++a)
#pragma unroll
        for (int b = 0; b < 2; ++b)
#pragma unroll
            for (int m = 0; m < 4; ++m)
#pragma unroll
                for (int n = 0; n < 2; ++n) acc[a][b][m][n] = (f32x4){0.f, 0.f, 0.f, 0.f};
    bf16x8 At[4][2], B0[2][2], B1[2][2];
    const char* cA = (const char*)g.A + (size_t)cur.pm * tstep; const char* cB = (const char*)g.Bt + (size_t)cur.pn * tstep;
    S.a_ready(cur);
    if constexpr (SP2) {
        PG8_STAGE(PG8_SB(0, 0), cB, voffB); PG8_STAGE(PG8_SB(0, 1), cB + hstep, voffB); PG8_STAGE(PG8_SA(0, 0), cA, voffA); PG8_STAGE(PG8_SA(0, 1), cA + hstep, voffA);
        if (wr == 1) PG8_BAR;
        PG8_WAIT_V(2); PG8_BAR;
        PG8_STAGE(PG8_SB(1, 0), cB + kstep, voffB); PG8_STAGE(PG8_SA(1, 0), cA + kstep, voffA); PG8_STAGE(PG8_SB(1, 1), cB + hstep + kstep, voffB);
        PG8_WAIT_V(6); PG8_BAR;
    } else {
        PG8_STAGE(PG8_SB(0, 0), cB, voffB); PG8_STAGE(PG8_SA(0, 0), cA, voffA); PG8_STAGE(PG8_SB(0, 1), cB + hstep, voffB); PG8_STAGE(PG8_SA(0, 1), cA + hstep, voffA);
        if (wr == 1) PG8_BAR;
        PG8_WAIT_V(4); PG8_BAR;
        PG8_STAGE(PG8_SB(1, 0), cB + kstep, voffB); PG8_STAGE(PG8_SA(1, 0), cA + kstep, voffA); PG8_STAGE(PG8_SB(1, 1), cB + hstep + kstep, voffB);
        PG8_WAIT_V(6); PG8_BAR;
    }
    for (;;) {
        const bool has_next = S.next(ui + 1, nxt);
        const char* nA = has_next ? (const char*)g.A + (size_t)nxt.pm * tstep : cA; const char* nB = has_next ? (const char*)g.Bt + (size_t)nxt.pn * tstep : cB;
        for (int t = 0; t < nt; t += 2) {
            const bool last = (t == nt - 2);
            const char* a1 = cA + (size_t)(t + 1) * kstep;
            const char* a2 = last ? nA : cA + (size_t)(t + 2) * kstep; const char* b2 = last ? nB : cB + (size_t)(t + 2) * kstep;
            const char* a3 = a2 + kstep; const char* b3 = b2 + kstep;
            if (last && has_next) S.a_ready(nxt);
            if constexpr (SP2) {
            PG8_LDB(B0, 0, 0); PG8_LDB(B1, 0, 1); PG8_SCHED; PG8_LDA(At, 0, 0); PG8_STAGE(PG8_SA(1, 1), a1 + hstep, voffA);
            PG8_WAIT_V(8); PG8_WAIT_L(0); PG8_BAR; PG8_MMA(0, 0, At, B0); PG8_MMA(0, 1, At, B1); PG8_BAR; PG8_SCHED;
            PG8_LDA(At, 0, 1); PG8_STAGE(PG8_SB(0, 0), b2, voffB); PG8_STAGE(PG8_SB(0, 1), b2 + hstep, voffB); PG8_STAGE(PG8_SA(0, 0), a2, voffA);
            PG8_WAIT_V(8); PG8_WAIT_L(0); PG8_BAR; PG8_MMA(1, 0, At, B0); PG8_MMA(1, 1, At, B1); PG8_BAR; PG8_SCHED;
            PG8_LDB(B0, 1, 0); PG8_LDB(B1, 1, 1); PG8_SCHED; PG8_LDA(At, 1, 0); PG8_STAGE(PG8_SA(0, 1), a2 + hstep, voffA);
            PG8_WAIT_V(8); PG8_WAIT_L(0); PG8_BAR; PG8_MMA(0, 0, At, B0); PG8_MMA(0, 1, At, B1); PG8_BAR; PG8_SCHED;
            PG8_LDA(At, 1, 1); PG8_STAGE(PG8_SB(1, 0), b3, voffB); PG8_STAGE(PG8_SB(1, 1), b3 + hstep, voffB); PG8_STAGE(PG8_SA(1, 0), a3, voffA);
            PG8_WAIT_V(8); PG8_WAIT_L(0); PG8_BAR; PG8_MMA(1, 0, At, B0); PG8_MMA(1, 1, At, B1); PG8_BAR; PG8_SCHED;
            } else {
            PG8_LDB(B0, 0, 0); PG8_SCHED; PG8_LDA(At, 0, 0); PG8_STAGE(PG8_SA(1, 1), a1 + hstep, voffA);
            PG8_WAIT_L(8); PG8_BAR; PG8_WAIT_L(0); PG8_MMA(0, 0, At, B0); PG8_BAR; PG8_SCHED;
            PG8_LDB(B1, 0, 1); PG8_STAGE(PG8_SB(0, 0), b2, voffB);
            PG8_BAR; PG8_WAIT_L(0); PG8_MMA(0, 1, At, B1); PG8_BAR;
            PG8_LDA(At, 0, 1); PG8_STAGE(PG8_SA(0, 0), a2, voffA);
            PG8_BAR; PG8_WAIT_L(0); PG8_MMA(1, 0, At, B0); PG8_BAR; PG8_SCHED;
            PG8_STAGE(PG8_SB(0, 1), b2 + hstep, voffB);
            PG8_WAIT_V(6); PG8_BAR; PG8_MMA(1, 1, At, B1); PG8_BAR;
            PG8_LDB(B0, 1, 0); PG8_SCHED; PG8_LDA(At, 1, 0); PG8_STAGE(PG8_SA(0, 1), a2 + hstep, voffA);
            PG8_WAIT_L(8); PG8_BAR; PG8_WAIT_L(0); PG8_MMA(0, 0, At, B0); PG8_BAR; PG8_SCHED;
            PG8_LDB(B1, 1, 1); PG8_STAGE(PG8_SB(1, 0), b3, voffB);
            PG8_BAR; PG8_WAIT_L(0); PG8_MMA(0, 1, At, B1); PG8_BAR;
            PG8_LDA(At, 1, 1); PG8_STAGE(PG8_SA(1, 0), a3, voffA);
            PG8_BAR; PG8_WAIT_L(0); PG8_MMA(1, 0, At, B0); PG8_BAR; PG8_SCHED;
            PG8_STAGE(PG8_SB(1, 1), b3 + hstep, voffB);
            PG8_WAIT_V(6); PG8_BAR; PG8_MMA(1, 1, At, B1); PG8_BAR;
            }
        }
        if constexpr (ALIGN_EPI) { if (wr == 0) PG8_BAR; }
        if constexpr (!Epi::AFTER_DRAIN) { E(acc, cur, wr, wc, fr, fq); S.done(cur); }
        if (!has_next) break;
#pragma unroll
        for (int a = 0; a < 2; ++a)
#pragma unroll
            for (int b = 0; b < 2; ++b)
#pragma unroll
                for (int m = 0; m < 4; ++m)
#pragma unroll
                    for (int n = 0; n < 2; ++n) acc[a][b][m][n] = (f32x4){0.f, 0.f, 0.f, 0.f};
        cur = nxt; cA = nA; cB = nB; ++ui;
        if constexpr (ALIGN_EPI) { if (wr == 1) PG8_BAR; }
    }
    PG8_WAIT_V(0);
    if constexpr (!ALIGN_EPI) { if (wr == 0) PG8_BAR; }
    PG8_BAR;
    if constexpr (Epi::AFTER_DRAIN) { E.fused(acc, cur, wr, wc, fr, fq, lds, wid, lane); S.done(cur); }
#undef PG8_SA
#undef PG8_SB
#undef PG8_STAGE
#undef PG8_LDA
#undef PG8_LDB
#undef PG8_MMA
#undef PG8_WAIT_V
#undef PG8_WAIT_L
#undef PG8_BAR
#undef PG8_SCHED
}
}

constexpr int MTOK = 16 * 2048, SEQ = 2048, DM = 1024, DIN = 2560, WP = 512, WC = 512;
constexpr int LDS_BYTES = 131072, NTHR = 512;
constexpr size_t WS_WIN = 0, WS_PW = WS_WIN + (size_t)DIN * DM * 2, WS_WOUT = WS_PW + (size_t)WC * WC * 2, WS_HN = WS_WOUT + (size_t)DM * DM * 2,
                 WS_P = WS_HN + (size_t)MTOK * DM * 2, WS_HC = WS_P + (size_t)MTOK * 2048 * 2, WS_Y = WS_HC + (size_t)MTOK * WC * 2, WS_PART = WS_Y + (size_t)MTOK * DM * 2,
                 WS_END = WS_PART + (size_t)MTOK * 16 * 4;
#define LAS __attribute__((address_space(3)))
typedef unsigned short bf16;
typedef float f32x4 __attribute__((ext_vector_type(4)));
typedef float f32x2 __attribute__((ext_vector_type(2)));
typedef unsigned u32x4 __attribute__((ext_vector_type(4)));
typedef unsigned u32x2 __attribute__((ext_vector_type(2)));
#define LDS_WAIT() asm volatile("s_waitcnt lgkmcnt(0)" ::: "memory")
using pg8::cvt_pk_bf16; using pg8::silu; using pg8::bf_lo; using pg8::bf_hi;

struct Params {
    const float *x, *norm_g, *w_in, *pool_w, *pool_b, *pool_scale, *conv_dw, *conv_b, *ln_g, *ln_b, *pw_w, *pw_b, *w_out, *final_g;
    float* out; unsigned char* ws;
};

__device__ __forceinline__ float wave_sum(float v) {
#pragma unroll
    for (int o = 1; o < 64; o <<= 1) v += __shfl_xor(v, o);
    return v;
}
__device__ __forceinline__ void transpose_item(const float* W, int ldw, int scol0, int k0, bf16* WT, int ldt, int drow0, LAS float* scr, int lane) {
#pragma unroll 8
    for (int i = 0; i < 32; ++i) { const int kk = 2 * i + (lane >> 5); scr[kk * 33 + (lane & 31)] = W[(size_t)(k0 + kk) * ldw + scol0 + (lane & 31)]; }
    LDS_WAIT();
    const int c = lane & 7;
#pragma unroll
    for (int j = 0; j < 4; ++j) { const int n = (lane >> 3) + 8 * j; const LAS float* s = scr + (8 * c) * 33 + n;
        u32x4 o; o.x = cvt_pk_bf16(s[0 * 33], s[1 * 33]); o.y = cvt_pk_bf16(s[2 * 33], s[3 * 33]); o.z = cvt_pk_bf16(s[4 * 33], s[5 * 33]); o.w = cvt_pk_bf16(s[6 * 33], s[7 * 33]);
        *(u32x4*)(WT + (size_t)(drow0 + n) * ldt + k0 + 8 * c) = o; }
    LDS_WAIT();
}
__device__ __forceinline__ void poolfold_item(const float* w_in, const float* pool_w, bf16* WinT, int g, int k0, LAS float* scr, int lane) {
#pragma unroll
    for (int kk = 0; kk < 8; ++kk) { const f32x2 v = *(const f32x2*)(w_in + (size_t)(k0 + kk) * DIN + 128 * g + 2 * lane); *(LAS f32x2*)(scr + kk * 128 + 2 * lane) = v; }
    LDS_WAIT();
    float acc[8][2];
#pragma unroll
    for (int kk = 0; kk < 8; ++kk) { acc[kk][0] = 0.f; acc[kk][1] = 0.f; }
    const float* pw = pool_w + (size_t)g * 128 * 128 + lane;
#pragma unroll 2
    for (int c4 = 0; c4 < 32; ++c4) {
        float p[4][2];
#pragma unroll
        for (int cc = 0; cc < 4; ++cc) { p[cc][0] = pw[(4 * c4 + cc) * 128]; p[cc][1] = pw[(4 * c4 + cc) * 128 + 64]; }
#pragma unroll
        for (int kk = 0; kk < 8; ++kk) { const f32x4 wv = *(const LAS f32x4*)(scr + kk * 128 + 4 * c4);
#pragma unroll
            for (int cc = 0; cc < 4; ++cc) { acc[kk][0] += wv[cc] * p[cc][0]; acc[kk][1] += wv[cc] * p[cc][1]; } }
    }
#pragma unroll
    for (int h = 0; h < 2; ++h) { u32x4 o; o.x = cvt_pk_bf16(acc[0][h], acc[1][h]); o.y = cvt_pk_bf16(acc[2][h], acc[3][h]); o.z = cvt_pk_bf16(acc[4][h], acc[5][h]); o.w = cvt_pk_bf16(acc[6][h], acc[7][h]);
        *(u32x4*)(WinT + (size_t)(128 * g + lane + 64 * h) * DM + k0) = o; }
    LDS_WAIT();
}

__device__ __forceinline__ void phase_prep(const Params& p, LAS unsigned char* lds, int bid, int G) {
    const int tid = threadIdx.x, lane = tid & 63, wave = __builtin_amdgcn_readfirstlane(tid >> 6);
    LAS float* scr = (LAS float*)(lds + wave * 8704);
    bf16* WinT = (bf16*)(p.ws + WS_WIN); bf16* PwT = (bf16*)(p.ws + WS_PW); bf16* WoutT = (bf16*)(p.ws + WS_WOUT); bf16* HN = (bf16*)(p.ws + WS_HN);
    const int gw = bid * 8 + wave, NGW = G * 8;
    for (int t = gw; t < 2176; t += NGW) {
        if (t < 512) { poolfold_item(p.w_in, p.pool_w, WinT, t >> 7, 8 * (t & 127), scr, lane); }
        else if (t < 1536) { const int it = t - 512, kb = it >> 6, nb = it & 63, n = 512 + 32 * nb; int scol;
            if (n < 1024 || n >= 2048) scol = n; else { const int q = (n - 1024) >> 8, r = (n - 1024) & 255; scol = r < 128 ? 1024 + 128 * q + r : 1536 + 128 * q + (r - 128); }
            transpose_item(p.w_in, DIN, scol, 64 * kb, WinT, DM, n, scr, lane); }
        else if (t < 1664) { const int it = t - 1536, kb = it >> 4, nb = it & 15; transpose_item(p.pw_w, WC, 32 * nb, 64 * kb, PwT, WC, 32 * nb, scr, lane); }
        else { const int it = t - 1664, kb = it >> 5, nb = it & 31; transpose_item(p.w_out, DM, 32 * nb, 64 * kb, WoutT, DM, 32 * nb, scr, lane); }
    }
    f32x4 gv[4];
#pragma unroll
    for (int j = 0; j < 4; ++j) gv[j] = *((const f32x4*)p.norm_g + lane + 64 * j);
    for (int m = gw; m < MTOK; m += NGW) {
        const f32x4* xr = (const f32x4*)(p.x + (size_t)m * DM) + lane; f32x4 v[4]; float s = 0.f;
#pragma unroll
        for (int j = 0; j < 4; ++j) { v[j] = xr[64 * j]; s += (v[j].x * v[j].x + v[j].y * v[j].y) + (v[j].z * v[j].z + v[j].w * v[j].w); }
        const float r = 1.0f / sqrtf(wave_sum(s) * (1.0f / DM) + 1e-6f);
        u32x2* o8 = (u32x2*)(HN + (size_t)m * DM) + lane;
#pragma unroll
        for (int j = 0; j < 4; ++j) { const f32x4 y = v[j] * r * gv[j]; u32x2 w; w.x = cvt_pk_bf16(y.x, y.y); w.y = cvt_pk_bf16(y.z, y.w); o8[64 * j] = w; }
    }
}

__device__ __forceinline__ void phase_mixer(const Params& p, LAS unsigned char* lds, int bid, int G) {
    const int tid = threadIdx.x, lane = tid & 63, wave = __builtin_amdgcn_readfirstlane(tid >> 6);
    const bf16* P = (const bf16*)(p.ws + WS_P); bf16* HC = (bf16*)(p.ws + WS_HC); bf16* Y = (bf16*)(p.ws + WS_Y);
    LAS unsigned char* Hs = lds;
    LAS float* Cs = (LAS float*)(lds + 62 * 1024);
    const int cp = tid & 255, th = tid >> 8;
    f32x2 tw[31];
#pragma unroll
    for (int j = 0; j < 31; ++j) tw[j] = *(const f32x2*)(p.conv_dw + j * WC + 2 * cp);
    const f32x2 cb = *(const f32x2*)(p.conv_b + 2 * cp);
    const int pg = lane >> 4, pw_ = 2 << pg, pc0 = 8 * lane;
    f32x4 pb0 = *(const f32x4*)(p.pool_b + pc0), pb1 = *(const f32x4*)(p.pool_b + pc0 + 4), ps0 = *(const f32x4*)(p.pool_scale + pc0), ps1 = *(const f32x4*)(p.pool_scale + pc0 + 4);
    const f32x4 lg0 = *(const f32x4*)(p.ln_g + 4 * lane), lg1 = *(const f32x4*)(p.ln_g + 256 + 4 * lane), lb0 = *(const f32x4*)(p.ln_b + 4 * lane), lb1 = *(const f32x4*)(p.ln_b + 256 + 4 * lane);
    for (int tile = bid; tile < MTOK / 32; tile += G) {
        const int t0 = tile * 32, s0 = t0 & (SEQ - 1);
        for (int i = tid; i < 62 * 64; i += NTHR) { const int r = i >> 6, ch = i & 63; u32x4 v = (u32x4){0u, 0u, 0u, 0u};
            if (s0 - 30 + r >= 0) v = *(const u32x4*)(P + (size_t)(t0 - 30 + r) * 2048 + 1024 + ch * 8);
            *(LAS u32x4*)(Hs + r * 1024 + ch * 16) = v; }
        {
            const int tf = t0 + 4 * wave, sf = s0 + 4 * wave;
            float sm[4][8], uc[4][8];
#pragma unroll
            for (int r = 0; r < 4; ++r)
#pragma unroll
                for (int e = 0; e < 8; ++e) { sm[r][e] = 0.f; uc[r][e] = 0.f; }
#pragma unroll
            for (int j = 0; j < 19; ++j) {
                u32x4 v = (u32x4){0u, 0u, 0u, 0u};
                if (j >= 16 - pw_ && sf - 15 + j >= 0) v = *(const u32x4*)(P + (size_t)(tf - 15 + j) * 2048 + pc0);
                float f[8] = {bf_lo(v.x), bf_hi(v.x), bf_lo(v.y), bf_hi(v.y), bf_lo(v.z), bf_hi(v.z), bf_lo(v.w), bf_hi(v.w)};
#pragma unroll
                for (int r = 0; r < 4; ++r) { const int d = 15 + r - j;
                    if (d >= 0 && d < 16) { const float msk = d < pw_ ? 1.f : 0.f;
#pragma unroll
                        for (int e = 0; e < 8; ++e) sm[r][e] += msk * f[e]; }
                    if (d == 0) {
#pragma unroll
                        for (int e = 0; e < 8; ++e) uc[r][e] = f[e]; } }
            }
#pragma unroll
            for (int r = 0; r < 4; ++r) { const int s = sf + r; const float inv = 1.0f / (float)(s + 1 < pw_ ? s + 1 : pw_);
                const u32x4 gt = *(const u32x4*)(P + (size_t)(tf + r) * 2048 + 512 + pc0);
                const float gf[8] = {bf_lo(gt.x), bf_hi(gt.x), bf_lo(gt.y), bf_hi(gt.y), bf_lo(gt.z), bf_hi(gt.z), bf_lo(gt.w), bf_hi(gt.w)};
                const float pbv[8] = {pb0.x, pb0.y, pb0.z, pb0.w, pb1.x, pb1.y, pb1.z, pb1.w}, psv[8] = {ps0.x, ps0.y, ps0.z, ps0.w, ps1.x, ps1.y, ps1.z, ps1.w};
                float y[8];
#pragma unroll
                for (int e = 0; e < 8; ++e) y[e] = (sm[r][e] * inv - uc[r][e] + pbv[e]) * psv[e] * gf[e];
                u32x4 w; w.x = cvt_pk_bf16(y[0], y[1]); w.y = cvt_pk_bf16(y[2], y[3]); w.z = cvt_pk_bf16(y[4], y[5]); w.w = cvt_pk_bf16(y[6], y[7]);
                *(u32x4*)(Y + (size_t)(tf + r) * DM + pc0) = w; }
        }
        __syncthreads();
        {
            f32x2 a[16];
#pragma unroll
            for (int r = 0; r < 16; ++r) a[r] = cb;
            const LAS unsigned* hp = (const LAS unsigned*)(Hs + (th * 16) * 1024 + cp * 4);
#pragma unroll
            for (int i = 0; i < 46; ++i) { const unsigned w = hp[i * 256]; const f32x2 v = (f32x2){bf_lo(w), bf_hi(w)};
#pragma unroll
                for (int r = 0; r < 16; ++r) { const int j = i - r; if (j >= 0 && j <= 30) a[r] += tw[j] * v; } }
#pragma unroll
            for (int r = 0; r < 16; ++r) *(LAS f32x2*)(Cs + (th * 16 + r) * 512 + 2 * cp) = a[r];
        }
        __syncthreads();
#pragma unroll
        for (int rr = 0; rr < 4; ++rr) { const int row = 4 * wave + rr;
            f32x4 v0 = *(const LAS f32x4*)(Cs + row * 512 + 4 * lane), v1 = *(const LAS f32x4*)(Cs + row * 512 + 256 + 4 * lane);
            const float mean = wave_sum((v0.x + v0.y) + (v0.z + v0.w) + (v1.x + v1.y) + (v1.z + v1.w)) * (1.0f / 512.0f);
            v0 = v0 - mean; v1 = v1 - mean;
            const float var = wave_sum((v0.x * v0.x + v0.y * v0.y) + (v0.z * v0.z + v0.w * v0.w) + (v1.x * v1.x + v1.y * v1.y) + (v1.z * v1.z + v1.w * v1.w)) * (1.0f / 512.0f);
            const float rstd = 1.0f / sqrtf(var + 1e-5f);
            v0 = v0 * rstd * lg0 + lb0; v1 = v1 * rstd * lg1 + lb1;
            u32x2 w0, w1; w0.x = cvt_pk_bf16(silu(v0.x), silu(v0.y)); w0.y = cvt_pk_bf16(silu(v0.z), silu(v0.w)); w1.x = cvt_pk_bf16(silu(v1.x), silu(v1.y)); w1.y = cvt_pk_bf16(silu(v1.z), silu(v1.w));
            bf16* o = HC + (size_t)(t0 + row) * WC; *(u32x2*)(o + 4 * lane) = w0; *(u32x2*)(o + 256 + 4 * lane) = w1; }
        __syncthreads();
    }
}

__device__ __forceinline__ void phase_final(const Params& p, int bid, int G) {
    const int tid = threadIdx.x, lane = tid & 63, wave = __builtin_amdgcn_readfirstlane(tid >> 6);
    const float* part = (const float*)(p.ws + WS_PART);
    const int gw = bid * 8 + wave, NGW = G * 8;
    f32x4 gv[4];
#pragma unroll
    for (int j = 0; j < 4; ++j) gv[j] = *((const f32x4*)p.final_g + lane + 64 * j);
    for (int m = gw; m < MTOK; m += NGW) {
        float s = lane < 16 ? part[(size_t)m * 16 + lane] : 0.f;
        s = wave_sum(s);
        const float r = 1.0f / sqrtf(s * (1.0f / DM) + 1e-6f);
        f32x4* o = (f32x4*)(p.out + (size_t)m * DM) + lane;
#pragma unroll
        for (int j = 0; j < 4; ++j) { const f32x4 v = o[64 * j]; o[64 * j] = v * r * gv[j]; }
    }
}

__global__ void __launch_bounds__(NTHR, 2) fwd_mega(Params p) {
    extern __shared__ __attribute__((aligned(16))) unsigned char lds_raw[];
    LAS unsigned char* lds = (LAS unsigned char*)lds_raw;
    cg::grid_group grid = cg::this_grid();
    const int bid = blockIdx.x, G = gridDim.x;
    const bf16* WinT = (const bf16*)(p.ws + WS_WIN); const bf16* PwT = (const bf16*)(p.ws + WS_PW); const bf16* WoutT = (const bf16*)(p.ws + WS_WOUT);
    const bf16* HN = (const bf16*)(p.ws + WS_HN); bf16* P = (bf16*)(p.ws + WS_P); const bf16* HC = (const bf16*)(p.ws + WS_HC); bf16* Y = (bf16*)(p.ws + WS_Y);
    float* part = (float*)(p.ws + WS_PART);

    phase_prep(p, lds, bid, G);
    grid.sync();
    {
        pg8::Gemm g{HN, WinT, MTOK, DIN, DM}; pg8::StaticOrder S; S.init(MTOK, DIN, G, bid);
        pg8::EpiProj E{P};
        pg8::gemm_phase<pg8::EpiProj, pg8::StaticOrder, true, true>(lds, g, S, E);
    }
    grid.sync();
    phase_mixer(p, lds, bid, G);
    grid.sync();
    {
        pg8::Gemm g{HC, PwT, MTOK, WC, WC}; pg8::StaticOrder S; S.init(MTOK, WC, G, bid);
        pg8::EpiPw E{P, Y, p.pw_b};
        pg8::gemm_phase<pg8::EpiPw, pg8::StaticOrder, true, true>(lds, g, S, E);
    }
    grid.sync();
    {
        pg8::Gemm g{Y, WoutT, MTOK, DM, DM}; pg8::StaticOrder S; S.init(MTOK, DM, G, bid);
        pg8::EpiOut E{p.x, p.out, part};
        pg8::gemm_phase<pg8::EpiOut, pg8::StaticOrder, true, true>(lds, g, S, E);
    }
    grid.sync();
    phase_final(p, bid, G);
}

extern "C" void kernel_launch(void* const* d_in, const int* in_sizes, int n_in, void* d_out, int out_size, void* d_ws, size_t ws_size, hipStream_t stream) {
    static int grid_blocks = 0;
    if (grid_blocks == 0) {
        if (n_in != 14 || in_sizes[0] != MTOK * DM || out_size != MTOK * DM || ws_size < WS_END) { fprintf(stderr, "kernel_launch: unexpected shapes (n_in %d, ws %zu)\n", n_in, ws_size); grid_blocks = -1; return; }
        int dev = 0, cus = 0, per_cu = 0;
        (void)hipGetDevice(&dev); (void)hipDeviceGetAttribute(&cus, hipDeviceAttributeMultiprocessorCount, dev);
        if (hipFuncSetAttribute((const void*)fwd_mega, hipFuncAttributeMaxDynamicSharedMemorySize, LDS_BYTES) != hipSuccess) { fprintf(stderr, "kernel_launch: hipFuncSetAttribute failed\n"); grid_blocks = -1; return; }
        if (hipOccupancyMaxActiveBlocksPerMultiprocessor(&per_cu, (const void*)fwd_mega, NTHR, LDS_BYTES) != hipSuccess || per_cu < 1) { fprintf(stderr, "kernel_launch: occupancy query failed (%d)\n", per_cu); (void)hipGetLastError(); per_cu = 1; }
        if (per_cu > 1) per_cu = 1;
        grid_blocks = cus * per_cu;
    }
    if (grid_blocks < 0) return;
    Params p{};
    p.x = (const float*)d_in[0]; p.norm_g = (const float*)d_in[1]; p.w_in = (const float*)d_in[2]; p.pool_w = (const float*)d_in[3]; p.pool_b = (const float*)d_in[4];
    p.pool_scale = (const float*)d_in[5]; p.conv_dw = (const float*)d_in[6]; p.conv_b = (const float*)d_in[7]; p.ln_g = (const float*)d_in[8]; p.ln_b = (const float*)d_in[9];
    p.pw_w = (const float*)d_in[10]; p.pw_b = (const float*)d_in[11]; p.w_out = (const float*)d_in[12]; p.final_g = (const float*)d_in[13];
    p.out = (float*)d_out; p.ws = (unsigned char*)d_ws;
    void* args[] = {&p};
    hipError_t e = hipLaunchCooperativeKernel((const void*)fwd_mega, dim3(grid_blocks), dim3(NTHR), args, LDS_BYTES, stream);
    if (e != hipSuccess) fprintf(stderr, "kernel_launch: cooperative launch failed: %s (grid %d)\n", hipGetErrorString(e), grid_blocks);
}
```

```cpp
#include <hip/hip_runtime.h>
#include <cstdio>
#include <cstdint>
namespace pg8 {
#define PG8_LAS __attribute__((address_space(3)))
typedef unsigned short bf16_t;
typedef short bf16x8 __attribute__((ext_vector_type(8)));
typedef float f32x4 __attribute__((ext_vector_type(4)));
typedef unsigned u32x4 __attribute__((ext_vector_type(4)));
constexpr int BM = 256, BK = 64, HALF = 128, HTB = HALF * BK * 2  , STAGE_BYTES = 8 * HTB, NXCD = 8, WGM = 8;

__host__ __device__ __forceinline__ int lds_byte(int r, int c) { const int st = (r >> 4) * 2 + (c >> 5), rr = r & 15, cc = c & 31, ob = rr * 64 + cc * 2; return st * 1024 + (ob ^ (((ob >> 9) & 1) << 5)); }
__host__ __device__ __forceinline__ void stage_rc(int b, int& R, int& C) { const int st = b / 1024, sb = b % 1024, swz = sb ^ (((sb >> 9) & 1) << 5); R = (st >> 1) * 16 + swz / 64; C = (st & 1) * 32 + (swz % 64) / 2; }
__host__ __device__ __forceinline__ int perm32(int rho) { const int n = rho >> 4, i = rho & 15; return 8 * (i >> 2) + 4 * n + (i & 3); }

struct Unit { int pm, pn; };
struct Gemm { const bf16_t* A; const bf16_t* Bt; int M, N, K; };

struct StaticOrder {
    int nM, nN, nwg, G, c;
    __host__ __device__ void init(int M, int N, int G_, int c_) { nM = M / BM; nN = N / BM; nwg = nM * nN; G = G_; c = c_; }
    __host__ __device__ bool next(int i, Unit& u) const {
        const long L = (long)i * G + c; if (L >= nwg) return false;
        int wgid = (int)L; { const int q = nwg / NXCD, r = nwg % NXCD, xcd = wgid % NXCD, off = wgid / NXCD; wgid = (xcd < r ? xcd * (q + 1) : r * (q + 1) + (xcd - r) * q) + off; }
        const int nig = WGM * nN, gid = wgid / nig, fm = gid * WGM, gsz = (nM - fm) < WGM ? (nM - fm) : WGM;
        u.pm = fm + ((wgid % nig) % gsz); u.pn = (wgid % nig) / gsz; return true;
    }
    __device__ __forceinline__ void a_ready(const Unit&) const {}
    __device__ __forceinline__ void done(const Unit&) const {}
};
__device__ __forceinline__ unsigned cvt_pk_bf16(float lo, float hi) { unsigned r; asm volatile("v_cvt_pk_bf16_f32 %0, %1, %2" : "=v"(r) : "v"(lo), "v"(hi)); return r; }
typedef float f32x2 __attribute__((ext_vector_type(2)));

__device__ __forceinline__ float sigm(float v) { return __builtin_amdgcn_rcpf(1.0f + __expf(-v)); }
__device__ __forceinline__ float silu(float v) { return v * sigm(v); }
struct EpiProj {
    static constexpr bool PERM = true, AFTER_DRAIN = false;
    bf16_t* P;
    __device__ __forceinline__ void operator()(const f32x4 (&acc)[2][2][4][2], const Unit& u, int wr, int wc, int fr, int fq) const {
        const int row0 = u.pm * BM + wr * 64 + fr; const int pn = u.pn;
        if (pn >= 4 && pn < 8) {
            const int col0 = 1024 + 128 * (pn - 4) + wc * 32 + 8 * fq;
#pragma unroll
            for (int ai = 0; ai < 2; ++ai)
#pragma unroll
                for (int m = 0; m < 4; ++m) { bf16_t* rowp = P + (size_t)(row0 + ai * HALF + m * 16) * 2048 + col0;
                    const f32x4 v0 = acc[ai][0][m][0], v1 = acc[ai][0][m][1], g0 = acc[ai][1][m][0], g1 = acc[ai][1][m][1];
                    u32x4 w; w.x = cvt_pk_bf16(v0[0] * sigm(g0[0]), v0[1] * sigm(g0[1])); w.y = cvt_pk_bf16(v0[2] * sigm(g0[2]), v0[3] * sigm(g0[3]));
                    w.z = cvt_pk_bf16(v1[0] * sigm(g1[0]), v1[1] * sigm(g1[1])); w.w = cvt_pk_bf16(v1[2] * sigm(g1[2]), v1[3] * sigm(g1[3]));
                    *(u32x4*)rowp = w; }
        } else {
            const int colbase = pn < 4 ? 256 * pn : 1536 + 256 * (pn - 8); const bool act = pn >= 2;
            const int col0 = colbase + wc * 32 + 8 * fq;
#pragma unroll
            for (int ai = 0; ai < 2; ++ai)
#pragma unroll
                for (int m = 0; m < 4; ++m) { bf16_t* rowp = P + (size_t)(row0 + ai * HALF + m * 16) * 2048 + col0;
#pragma unroll
                    for (int bj = 0; bj < 2; ++bj) { f32x4 v0 = acc[ai][bj][m][0], v1 = acc[ai][bj][m][1];
                        if (act) {
#pragma unroll
                            for (int j = 0; j < 4; ++j) { v0[j] = silu(v0[j]); v1[j] = silu(v1[j]); } }
                        u32x4 w; w.x = cvt_pk_bf16(v0[0], v0[1]); w.y = cvt_pk_bf16(v0[2], v0[3]); w.z = cvt_pk_bf16(v1[0], v1[1]); w.w = cvt_pk_bf16(v1[2], v1[3]);
                        *(u32x4*)(rowp + bj * HALF) = w; } }
        }
    }
};
__device__ __forceinline__ float bf_lo(unsigned w) { return __uint_as_float(w << 16); }
__device__ __forceinline__ float bf_hi(unsigned w) { return __uint_as_float(w & 0xffff0000u); }
struct EpiPw {
    static constexpr bool PERM = true, AFTER_DRAIN = false;
    const bf16_t* P; bf16_t* Y; const float* bias;
    __device__ __forceinline__ void operator()(const f32x4 (&acc)[2][2][4][2], const Unit& u, int wr, int wc, int fr, int fq) const {
        const int row0 = u.pm * BM + wr * 64 + fr; const int col0 = u.pn * BM + wc * 32 + 8 * fq;
        f32x4 bv[2][2];
#pragma unroll
        for (int bj = 0; bj < 2; ++bj)
#pragma unroll
            for (int n = 0; n < 2; ++n) bv[bj][n] = *(const f32x4*)(bias + col0 + bj * HALF + 4 * n);
#pragma unroll
        for (int ai = 0; ai < 2; ++ai)
#pragma unroll
            for (int m = 0; m < 4; ++m) { const size_t row = (size_t)(row0 + ai * HALF + m * 16);
#pragma unroll
                for (int bj = 0; bj < 2; ++bj) { const u32x4 gt = *(const u32x4*)(P + row * 2048 + 1536 + col0 + bj * HALF);
                    const f32x4 v0 = acc[ai][bj][m][0] + bv[bj][0], v1 = acc[ai][bj][m][1] + bv[bj][1];
                    u32x4 w; w.x = cvt_pk_bf16(v0[0] * bf_lo(gt.x), v0[1] * bf_hi(gt.x)); w.y = cvt_pk_bf16(v0[2] * bf_lo(gt.y), v0[3] * bf_hi(gt.y));
                    w.z = cvt_pk_bf16(v1[0] * bf_lo(gt.z), v1[1] * bf_hi(gt.z)); w.w = cvt_pk_bf16(v1[2] * bf_lo(gt.w), v1[3] * bf_hi(gt.w));
                    *(u32x4*)(Y + row * 1024 + 512 + col0 + bj * HALF) = w; } }
    }
};
constexpr int MTOK_ = 16 * 2048;
struct EpiOut {
    static constexpr bool PERM = false, AFTER_DRAIN = false;
    const float* x; float* out; float* part;
    __device__ __forceinline__ void operator()(const f32x4 (&acc)[2][2][4][2], const Unit& u, int wr, int wc, int fr, int fq) const {
        const int row0 = u.pm * BM + wr * 64 + fr, col0 = u.pn * BM + wc * 32 + 4 * fq;
#pragma unroll
        for (int ai = 0; ai < 2; ++ai)
#pragma unroll
            for (int m = 0; m < 4; ++m) { const int row = row0 + ai * HALF + m * 16; const size_t off = (size_t)row * 1024 + col0; float ss = 0.f;
#pragma unroll
                for (int bj = 0; bj < 2; ++bj)
#pragma unroll
                    for (int n = 0; n < 2; ++n) { const f32x4 xv = *(const f32x4*)(x + off + bj * HALF + n * 16); const f32x4 o = xv + acc[ai][bj][m][n];
                        *(f32x4*)(out + off + bj * HALF + n * 16) = o; ss += (o[0] * o[0] + o[1] * o[1]) + (o[2] * o[2] + o[3] * o[3]); }
                ss += __shfl_xor(ss, 16); ss += __shfl_xor(ss, 32);
                if (fq == 0) part[((size_t)u.pn * MTOK_ + row) * 4 + wc] = ss;
                asm volatile("" ::: "memory"); }
    }
};
template <class Epi, class Sched, bool ALIGN_EPI = false, bool SP2 = false>
__device__ __forceinline__ void gemm_phase(PG8_LAS unsigned char* lds, const Gemm g, const Sched& S, const Epi& E) {
    const int tid = threadIdx.x, wid = __builtin_amdgcn_readfirstlane(tid >> 6), lane = tid & 63, wr = wid >> 2, wc = wid & 3, fr = lane & 15, fq = lane >> 4;
    const int K = g.K, nt = K / BK;
    unsigned voffA[2], voffB[2];
#pragma unroll
    for (int i = 0; i < 2; ++i) { int R, C; stage_rc(tid * 16 + i * 8192, R, C); const int Rb = Epi::PERM ? ((R & ~31) + perm32(R & 31)) : R;
        voffA[i] = (unsigned)(R * K + C) * 2u; voffB[i] = (unsigned)(Rb * K + C) * 2u; }
    const size_t kstep = (size_t)(BK * 2);
    const size_t hstep = (size_t)HALF * K * 2;
    const size_t tstep = 2 * hstep;
    const unsigned ldsw = (unsigned)wid * 1024u;
    const int aoff = lds_byte(wr * 64 + fr, fq * 8), boff = lds_byte(wc * 32 + fr, fq * 8);
#define PG8_SA(b, h) (((b) * 2 + (h)) * HTB)
#define PG8_SB(b, h) ((4 + (b) * 2 + (h)) * HTB)
#define PG8_STAGE(bufoff, gbase, voff) do { _Pragma("unroll") for (int _i = 0; _i < 2; ++_i) \
        __builtin_amdgcn_global_load_lds((const unsigned*)((const char*)(gbase) + (voff)[_i]), (PG8_LAS unsigned*)(lds + (bufoff) + ldsw + _i * 8192), 16, 0, 0); } while (0)
#define PG8_LDA(dst, b, h) do { _Pragma("unroll") for (int m = 0; m < 4; ++m) _Pragma("unroll") for (int k = 0; k < 2; ++k) dst[m][k] = *(const PG8_LAS bf16x8*)(lds + PG8_SA(b, h) + aoff + m * 2048 + k * 1024); } while (0)
#define PG8_LDB(dst, b, h) do { _Pragma("unroll") for (int n = 0; n < 2; ++n) _Pragma("unroll") for (int k = 0; k < 2; ++k) dst[n][k] = *(const PG8_LAS bf16x8*)(lds + PG8_SB(b, h) + boff + n * 2048 + k * 1024); } while (0)
#define PG8_MMA(ai, bj, At, Bt) do { __builtin_amdgcn_s_setprio(1); _Pragma("unroll") for (int m = 0; m < 4; ++m) _Pragma("unroll") for (int n = 0; n < 2; ++n) _Pragma("unroll") for (int k = 0; k < 2; ++k) \
        acc[ai][bj][m][n] = __builtin_amdgcn_mfma_f32_16x16x32_bf16(Bt[n][k], At[m][k], acc[ai][bj][m][n], 0, 0, 0); __builtin_amdgcn_s_setprio(0); } while (0)
#define PG8_WAIT_V(n) asm volatile("s_waitcnt vmcnt(" #n ")" ::: "memory")
#define PG8_WAIT_L(n) asm volatile("s_waitcnt lgkmcnt(" #n ")" ::: "memory")
#define PG8_BAR __builtin_amdgcn_s_barrier()
#define PG8_SCHED __builtin_amdgcn_sched_barrier(0)
    Unit cur, nxt; int ui = 0;
    if (!S.next(0, cur)) return;
    f32x4 acc[2][2][4][2];
#pragma unroll
    for (int a = 0; a < 2; ++a)
#pragma unroll
        for (int b = 0; b < 2; ++b)
#pragma unroll
            for (int m = 0; m < 4; ++m)
#pragma unroll
                for (int n = 0; n < 2; ++n) acc[a][b][m][n] = (f32x4){0.f, 0.f, 0.f, 0.f};
    bf16x8 At[4][2], B0[2][2], B1[2][2];
    const char* cA = (const char*)g.A + (size_t)cur.pm * tstep; const char* cB = (const char*)g.Bt + (size_t)cur.pn * tstep;
    S.a_ready(cur);
    if constexpr (SP2) {
        PG8_STAGE(PG8_SB(0, 0), cB, voffB); PG8_STAGE(PG8_SB(0, 1), cB + hstep, voffB); PG8_STAGE(PG8_SA(0, 0), cA, voffA); PG8_STAGE(PG8_SA(0, 1), cA + hstep, voffA);
        if (wr == 1) PG8_BAR;
        PG8_WAIT_V(2); PG8_BAR;
        PG8_STAGE(PG8_SB(1, 0), cB + kstep, voffB); PG8_STAGE(PG8_SA(1, 0), cA + kstep, voffA); PG8_STAGE(PG8_SB(1, 1), cB + hstep + kstep, voffB);
        PG8_WAIT_V(6); PG8_BAR;
    } else {
        PG8_STAGE(PG8_SB(0, 0), cB, voffB); PG8_STAGE(PG8_SA(0, 0), cA, voffA); PG8_STAGE(PG8_SB(0, 1), cB + hstep, voffB); PG8_STAGE(PG8_SA(0, 1), cA + hstep, voffA);
        if (wr == 1) PG8_BAR;
        PG8_WAIT_V(4); PG8_BAR;
        PG8_STAGE(PG8_SB(1, 0), cB + kstep, voffB); PG8_STAGE(PG8_SA(1, 0), cA + kstep, voffA); PG8_STAGE(PG8_SB(1, 1), cB + hstep + kstep, voffB);
        PG8_WAIT_V(6); PG8_BAR;
    }
    for (;;) {
        const bool has_next = S.next(ui + 1, nxt);
        const char* nA = has_next ? (const char*)g.A + (size_t)nxt.pm * tstep : cA; const char* nB = has_next ? (const char*)g.Bt + (size_t)nxt.pn * tstep : cB;
        for (int t = 0; t < nt; t += 2) {
            const bool last = (t == nt - 2);
            const char* a1 = cA + (size_t)(t + 1) * kstep;
            const char* a2 = last ? nA : cA + (size_t)(t + 2) * kstep; const char* b2 = last ? nB : cB + (size_t)(t + 2) * kstep;
            const char* a3 = a2 + kstep; const char* b3 = b2 + kstep;
            if (last && has_next) S.a_ready(nxt);
            if constexpr (SP2) {
            PG8_LDB(B0, 0, 0); PG8_LDB(B1, 0, 1); PG8_SCHED; PG8_LDA(At, 0, 0); PG8_STAGE(PG8_SA(1, 1), a1 + hstep, voffA);
            PG8_WAIT_V(8); PG8_WAIT_L(0); PG8_BAR; PG8_MMA(0, 0, At, B0); PG8_MMA(0, 1, At, B1); PG8_BAR; PG8_SCHED;
            PG8_LDA(At, 0, 1); PG8_STAGE(PG8_SB(0, 0), b2, voffB); PG8_STAGE(PG8_SB(0, 1), b2 + hstep, voffB); PG8_STAGE(PG8_SA(0, 0), a2, voffA);
            PG8_WAIT_V(8); PG8_WAIT_L(0); PG8_BAR; PG8_MMA(1, 0, At, B0); PG8_MMA(1, 1, At, B1); PG8_BAR; PG8_SCHED;
            PG8_LDB(B0, 1, 0); PG8_LDB(B1, 1, 1); PG8_SCHED; PG8_LDA(At, 1, 0); PG8_STAGE(PG8_SA(0, 1), a2 + hstep, voffA);
            PG8_WAIT_V(8); PG8_WAIT_L(0); PG8_BAR; PG8_MMA(0, 0, At, B0); PG8_MMA(0, 1, At, B1); PG8_BAR; PG8_SCHED;
            PG8_LDA(At, 1, 1); PG8_STAGE(PG8_SB(1, 0), b3, voffB); PG8_STAGE(PG8_SB(1, 1), b3 + hstep, voffB); PG8_STAGE(PG8_SA(1, 0), a3, voffA);
            PG8_WAIT_V(8); PG8_WAIT_L(0); PG8_BAR; PG8_MMA(1, 0, At, B0); PG8_MMA(1, 1, At, B1); PG8_BAR; PG8_SCHED;
            } else {
            PG8_LDB(B0, 0, 0); PG8_SCHED; PG8_LDA(At, 0, 0); PG8_STAGE(PG8_SA(1, 1), a1 + hstep, voffA);
            PG8_WAIT_L(8); PG8_BAR; PG8_WAIT_L(0); PG8_MMA(0, 0, At, B0); PG8_BAR; PG8_SCHED;
            PG8_LDB(B1, 0, 1); PG8_STAGE(PG8_SB(0, 0), b2, voffB);
            PG8_BAR; PG8_WAIT_L(0); PG8_MMA(0, 1, At, B1); PG8_BAR;
            PG8_LDA(At, 0, 1); PG8_STAGE(PG8_SA(0, 0), a2, voffA);
            PG8_BAR; PG8_WAIT_L(0); PG8_MMA(1, 0, At, B0); PG8_BAR; PG8_SCHED;
            PG8_STAGE(PG8_SB(0, 1), b2 + hstep, voffB);
            PG8_WAIT_V(6); PG8_BAR; PG8_MMA(1, 1, At, B1); PG8_BAR;
            PG8_LDB(B0, 1, 0); PG8_SCHED; PG8_LDA(At, 1, 0); PG8_STAGE(PG8_SA(0, 1), a2 + hstep, voffA);
            PG8_WAIT_L(8); PG8_BAR; PG8_WAIT_L(0); PG8_MMA(0, 0, At, B0); PG8_BAR; PG8_SCHED;
            PG8_LDB(B1, 1, 1); PG8_STAGE(PG8_SB(1, 0), b3, voffB);
            PG8_BAR; PG8_WAIT_L(0); PG8_MMA(0, 1, At, B1); PG8_BAR;
            PG8_LDA(At, 1, 1); PG8_STAGE(PG8_SA(1, 0), a3, voffA);
            PG8_BAR; PG8_WAIT_L(0); PG8_MMA(1, 0, At, B0); PG8_BAR; PG8_SCHED;
            PG8_STAGE(PG8_SB(1, 1), b3 + hstep, voffB);
            PG8_WAIT_V(6); PG8_BAR; PG8_MMA(1, 1, At, B1); PG8_BAR;
            }
        }
        if constexpr (ALIGN_EPI) { if (wr == 0) PG8_BAR; }
        if constexpr (!Epi::AFTER_DRAIN) { E(acc, cur, wr, wc, fr, fq); S.done(cur); }
        if (!has_next) break;
#pragma unroll
        for (int a = 0; a < 2; ++a)
#pragma unroll
            for (int b = 0; b < 2; ++b)
#pragma unroll
                for (int m = 0; m < 4; ++m)
#pragma unroll
                    for (int n = 0; n < 2; ++n) acc[a][b][m][n] = (f32x4){0.f, 0.f, 0.f, 0.f};
        cur = nxt; cA = nA; cB = nB; ++ui;
        if constexpr (ALIGN_EPI) { if (wr == 1) PG8_BAR; }
    }
    PG8_WAIT_V(0);
    if constexpr (!ALIGN_EPI) { if (wr == 0) PG8_BAR; }
    PG8_BAR;
    if constexpr (Epi::AFTER_DRAIN) { E.fused(acc, cur, wr, wc, fr, fq, lds, wid, lane); S.done(cur); }
#undef PG8_SA
#undef PG8_SB
#undef PG8_STAGE
#undef PG8_LDA
#undef PG8_LDB
#undef PG8_MMA
#undef PG8_WAIT_V
#undef PG8_WAIT_L
#undef PG8_BAR
#undef PG8_SCHED
}
}

constexpr int MTOK = 16 * 2048, SEQ = 2048, DM = 1024, DIN = 2560, WP = 512, WC = 512;
constexpr int MISC_OFF = 131072, LDS_BYTES = 131072 + 256, NTHR = 512;
constexpr size_t WS_WIN = 0, WS_PW = WS_WIN + (size_t)DIN * DM * 2, WS_WOUT = WS_PW + (size_t)WC * WC * 2, WS_HN = WS_WOUT + (size_t)DM * DM * 2,
                 WS_P = WS_HN + (size_t)MTOK * DM * 2, WS_HC = WS_P + (size_t)MTOK * 2048 * 2, WS_Y = WS_HC + (size_t)MTOK * WC * 2, WS_PART = WS_Y + (size_t)MTOK * DM * 2,
                 WS_BAR = WS_PART + (size_t)MTOK * 16 * 4, WS_END = WS_BAR + 16384;
#define LAS __attribute__((address_space(3)))
typedef unsigned short bf16;
typedef float f32x4 __attribute__((ext_vector_type(4)));
typedef float f32x2 __attribute__((ext_vector_type(2)));
typedef unsigned u32x4 __attribute__((ext_vector_type(4)));
typedef unsigned u32x2 __attribute__((ext_vector_type(2)));
#define LDS_WAIT() asm volatile("s_waitcnt lgkmcnt(0)" ::: "memory")
using pg8::cvt_pk_bf16; using pg8::silu; using pg8::bf_lo; using pg8::bf_hi;

#define RLX_AGENT __ATOMIC_RELAXED, __HIP_MEMORY_SCOPE_AGENT
#define XB_TMO      128
#define XB_XCNT(j)  (256  + 64 * (j))
#define XB_XSUB(j)  (1280 + 64 * (j))
#define XB_XGEN(j)  (2304 + 64 * (j))
#define XB_TOP      3328
#define XB_TOPGEN   3392
#define XCD_BAR_WORDS 3456
#define XB_SPIN_CAP (1u << 18)

__device__ __forceinline__ unsigned xb_ld(unsigned* p)              { return __hip_atomic_load(p, __ATOMIC_RELAXED, __HIP_MEMORY_SCOPE_AGENT); }
__device__ __forceinline__ unsigned xb_add(unsigned* p, unsigned v) { return __hip_atomic_fetch_add(p, v, __ATOMIC_RELAXED, __HIP_MEMORY_SCOPE_AGENT); }
__device__ __forceinline__ unsigned xb_xcc_id() { return (unsigned)__builtin_amdgcn_s_getreg((3 << 11) | 20) & 0xFu; }
#define XB_SPIN(cond, bar) do { unsigned _sp = 0; while (cond) { __builtin_amdgcn_s_sleep(1); \
    if ((++_sp & 255u) == 0u) { if (xb_ld(&(bar)[XB_TMO])) break; if (_sp > XB_SPIN_CAP) { atomicAdd(&(bar)[XB_TMO], 1u); break; } } } } while (0)

struct XcdBarrier {
    unsigned* bar; unsigned x;
    volatile LAS unsigned* st;
};

__device__ __forceinline__ XcdBarrier xcd_barrier_post(unsigned* bar, volatile LAS unsigned* st) {
    XcdBarrier b; b.bar = bar; b.x = xb_xcc_id(); b.st = st;
    if (threadIdx.x == 0) (void)xb_add(&bar[XB_XCNT(b.x)], 1u);
    return b;
}
__device__ __forceinline__ void xcd_barrier_complete(unsigned* bar, unsigned x, unsigned& nloc, unsigned& nx) {
    const unsigned G = gridDim.x * gridDim.y * gridDim.z;
    unsigned sum, cnt, mine, sp = 0u;
    for (;;) {
        sum = 0u; cnt = 0u; mine = 0u;
#pragma unroll
        for (unsigned j = 0; j < 16; ++j) { const unsigned c = xb_ld(&bar[XB_XCNT(j)]); sum += c; cnt += (c > 0u) ? 1u : 0u; mine = (j == x) ? c : mine; }
        if (sum == G) break;
        __builtin_amdgcn_s_sleep(1);
        if ((++sp & 255u) == 0u) { if (xb_ld(&bar[XB_TMO])) break; if (sp > XB_SPIN_CAP) { atomicAdd(&bar[XB_TMO], 1u); break; } }
    }
    nloc = mine > 0u ? mine : 1u; nx = cnt > 0u ? cnt : 1u;
}

__device__ __forceinline__ void xcd_barrier(const XcdBarrier& b) {
    asm volatile("s_waitcnt vmcnt(0)" ::: "memory");
    __syncthreads();
    if (threadIdx.x == 0) {
        unsigned* bar = b.bar;
        __builtin_amdgcn_s_waitcnt(0);
        unsigned nloc = b.st[0], nx = b.st[1];
        if (nloc == 0u) { xcd_barrier_complete(bar, b.x, nloc, nx); b.st[0] = nloc; b.st[1] = nx; }
        const unsigned old = xb_add(&bar[XB_XSUB(b.x)], 1u);
        const unsigned gen = old / nloc;
        if (old + 1u == (gen + 1u) * nloc) {
            __builtin_amdgcn_fence(__ATOMIC_RELEASE, "agent");
            asm volatile("s_waitcnt vmcnt(0)" ::: "memory");
            const unsigned og = xb_add(&bar[XB_TOP], 1u);
            const unsigned tg = og / nx;
            if (og + 1u == (tg + 1u) * nx) xb_add(&bar[XB_TOPGEN], 1u);
            else XB_SPIN(xb_ld(&bar[XB_TOPGEN]) == tg, bar);
            __builtin_amdgcn_fence(__ATOMIC_ACQUIRE, "agent");
            xb_add(&bar[XB_XGEN(b.x)], 1u);
            asm volatile("s_waitcnt vmcnt(0)" ::: "memory");
        } else {
            XB_SPIN(xb_ld(&bar[XB_XGEN(b.x)]) == gen, bar);
            __builtin_amdgcn_fence(__ATOMIC_ACQUIRE, "agent");
            asm volatile("s_waitcnt vmcnt(0)" ::: "memory");
        }
    }
    __syncthreads();
}

struct Params {
    const float *x, *norm_g, *w_in, *pool_w, *pool_b, *pool_scale, *conv_dw, *conv_b, *ln_g, *ln_b, *pw_w, *pw_b, *w_out, *final_g;
    float* out; unsigned char* ws;
};

__device__ __forceinline__ float wave_sum(float v) {
#pragma unroll
    for (int o = 1; o < 64; o <<= 1) v += __shfl_xor(v, o);
    return v;
}
__device__ __forceinline__ void transpose_item(const float* W, int ldw, int scol0, int k0, bf16* WT, int ldt, int drow0, LAS float* scr, int lane) {
#pragma unroll 8
    for (int i = 0; i < 32; ++i) { const int kk = 2 * i + (lane >> 5); scr[kk * 33 + (lane & 31)] = W[(size_t)(k0 + kk) * ldw + scol0 + (lane & 31)]; }
    LDS_WAIT();
    const int c = lane & 7;
#pragma unroll
    for (int j = 0; j < 4; ++j) { const int n = (lane >> 3) + 8 * j; const LAS float* s = scr + (8 * c) * 33 + n;
        u32x4 o; o.x = cvt_pk_bf16(s[0 * 33], s[1 * 33]); o.y = cvt_pk_bf16(s[2 * 33], s[3 * 33]); o.z = cvt_pk_bf16(s[4 * 33], s[5 * 33]); o.w = cvt_pk_bf16(s[6 * 33], s[7 * 33]);
        *(u32x4*)(WT + (size_t)(drow0 + n) * ldt + k0 + 8 * c) = o; }
    LDS_WAIT();
}
__device__ __forceinline__ void poolfold_item(const float* w_in, const float* pool_w, bf16* WinT, int g, int k0, LAS float* scr, int lane) {
#pragma unroll
    for (int kk = 0; kk < 8; ++kk) { const f32x2 v = *(const f32x2*)(w_in + (size_t)(k0 + kk) * DIN + 128 * g + 2 * lane); *(LAS f32x2*)(scr + kk * 128 + 2 * lane) = v; }
    LDS_WAIT();
    float acc[8][2];
#pragma unroll
    for (int kk = 0; kk < 8; ++kk) { acc[kk][0] = 0.f; acc[kk][1] = 0.f; }
    const float* pw = pool_w + (size_t)g * 128 * 128 + lane;
#pragma unroll 2
    for (int c4 = 0; c4 < 32; ++c4) {
        float p[4][2];
#pragma unroll
        for (int cc = 0; cc < 4; ++cc) { p[cc][0] = pw[(4 * c4 + cc) * 128]; p[cc][1] = pw[(4 * c4 + cc) * 128 + 64]; }
#pragma unroll
        for (int kk = 0; kk < 8; ++kk) { const f32x4 wv = *(const LAS f32x4*)(scr + kk * 128 + 4 * c4);
#pragma unroll
            for (int cc = 0; cc < 4; ++cc) { acc[kk][0] += wv[cc] * p[cc][0]; acc[kk][1] += wv[cc] * p[cc][1]; } }
    }
#pragma unroll
    for (int h = 0; h < 2; ++h) { u32x4 o; o.x = cvt_pk_bf16(acc[0][h], acc[1][h]); o.y = cvt_pk_bf16(acc[2][h], acc[3][h]); o.z = cvt_pk_bf16(acc[4][h], acc[5][h]); o.w = cvt_pk_bf16(acc[6][h], acc[7][h]);
        *(u32x4*)(WinT + (size_t)(128 * g + lane + 64 * h) * DM + k0) = o; }
    LDS_WAIT();
}

__device__ __forceinline__ void phase_prep(const Params& p, LAS unsigned char* lds, int bid, int G) {
    const int tid = threadIdx.x, lane = tid & 63, wave = __builtin_amdgcn_readfirstlane(tid >> 6);
    LAS float* scr = (LAS float*)(lds + wave * 8704);
    bf16* WinT = (bf16*)(p.ws + WS_WIN); bf16* PwT = (bf16*)(p.ws + WS_PW); bf16* WoutT = (bf16*)(p.ws + WS_WOUT); bf16* HN = (bf16*)(p.ws + WS_HN);
    const int gw = bid * 8 + wave, NGW = G * 8;
    for (int t = gw; t < 2176; t += NGW) {
        if (t < 512) { poolfold_item(p.w_in, p.pool_w, WinT, t >> 7, 8 * (t & 127), scr, lane); }
        else if (t < 1536) { const int it = t - 512, kb = it >> 6, nb = it & 63, n = 512 + 32 * nb; int scol;
            if (n < 1024 || n >= 2048) scol = n; else { const int q = (n - 1024) >> 8, r = (n - 1024) & 255; scol = r < 128 ? 1024 + 128 * q + r : 1536 + 128 * q + (r - 128); }
            transpose_item(p.w_in, DIN, scol, 64 * kb, WinT, DM, n, scr, lane); }
        else if (t < 1664) { const int it = t - 1536, kb = it >> 4, nb = it & 15; transpose_item(p.pw_w, WC, 32 * nb, 64 * kb, PwT, WC, 32 * nb, scr, lane); }
        else { const int it = t - 1664, kb = it >> 5, nb = it & 31; transpose_item(p.w_out, DM, 32 * nb, 64 * kb, WoutT, DM, 32 * nb, scr, lane); }
    }
    f32x4 gv[4];
#pragma unroll
    for (int j = 0; j < 4; ++j) gv[j] = *((const f32x4*)p.norm_g + lane + 64 * j);
    for (int m = gw; m < MTOK; m += NGW) {
        const f32x4* xr = (const f32x4*)(p.x + (size_t)m * DM) + lane; f32x4 v[4]; float s = 0.f;
#pragma unroll
        for (int j = 0; j < 4; ++j) { v[j] = xr[64 * j]; s += (v[j].x * v[j].x + v[j].y * v[j].y) + (v[j].z * v[j].z + v[j].w * v[j].w); }
        const float r = 1.0f / sqrtf(wave_sum(s) * (1.0f / DM) + 1e-6f);
        u32x2* o8 = (u32x2*)(HN + (size_t)m * DM) + lane;
#pragma unroll
        for (int j = 0; j < 4; ++j) { const f32x4 y = v[j] * r * gv[j]; u32x2 w; w.x = cvt_pk_bf16(y.x, y.y); w.y = cvt_pk_bf16(y.z, y.w); o8[64 * j] = w; }
    }
}

__device__ __forceinline__ void phase_mixer(const Params& p, LAS unsigned char* lds, int bid, int G) {
    const int tid = threadIdx.x, lane = tid & 63, wave = __builtin_amdgcn_readfirstlane(tid >> 6);
    const bf16* P = (const bf16*)(p.ws + WS_P); bf16* HC = (bf16*)(p.ws + WS_HC); bf16* Y = (bf16*)(p.ws + WS_Y);
    LAS unsigned char* Hs = lds;
    LAS float* Cs = (LAS float*)(lds + 62 * 1024);
    const int cp = tid & 255, th = tid >> 8;
    f32x2 tw[31];
#pragma unroll
    for (int j = 0; j < 31; ++j) tw[j] = *(const f32x2*)(p.conv_dw + j * WC + 2 * cp);
    const f32x2 cb = *(const f32x2*)(p.conv_b + 2 * cp);
    const int pg = lane >> 4, pw_ = 2 << pg, pc0 = 8 * lane;
    f32x4 pb0 = *(const f32x4*)(p.pool_b + pc0), pb1 = *(const f32x4*)(p.pool_b + pc0 + 4), ps0 = *(const f32x4*)(p.pool_scale + pc0), ps1 = *(const f32x4*)(p.pool_scale + pc0 + 4);
    const f32x4 lg0 = *(const f32x4*)(p.ln_g + 4 * lane), lg1 = *(const f32x4*)(p.ln_g + 256 + 4 * lane), lb0 = *(const f32x4*)(p.ln_b + 4 * lane), lb1 = *(const f32x4*)(p.ln_b + 256 + 4 * lane);
    for (int tile = bid; tile < MTOK / 32; tile += G) {
        const int t0 = tile * 32, s0 = t0 & (SEQ - 1);
        for (int i = tid; i < 62 * 64; i += NTHR) { const int r = i >> 6, ch = i & 63; u32x4 v = (u32x4){0u, 0u, 0u, 0u};
            if (s0 - 30 + r >= 0) v = *(const u32x4*)(P + (size_t)(t0 - 30 + r) * 2048 + 1024 + ch * 8);
            *(LAS u32x4*)(Hs + r * 1024 + ch * 16) = v; }
        {
            const int tf = t0 + 4 * wave, sf = s0 + 4 * wave;
            float sm[4][8], uc[4][8];
#pragma unroll
            for (int r = 0; r < 4; ++r)
#pragma unroll
                for (int e = 0; e < 8; ++e) { sm[r][e] = 0.f; uc[r][e] = 0.f; }
#pragma unroll
            for (int j = 0; j < 19; ++j) {
                u32x4 v = (u32x4){0u, 0u, 0u, 0u};
                if (j >= 16 - pw_ && sf - 15 + j >= 0) v = *(const u32x4*)(P + (size_t)(tf - 15 + j) * 2048 + pc0);
                float f[8] = {bf_lo(v.x), bf_hi(v.x), bf_lo(v.y), bf_hi(v.y), bf_lo(v.z), bf_hi(v.z), bf_lo(v.w), bf_hi(v.w)};
#pragma unroll
                for (int r = 0; r < 4; ++r) { const int d = 15 + r - j;
                    if (d >= 0 && d < 16) { const float msk = d < pw_ ? 1.f : 0.f;
#pragma unroll
                        for (int e = 0; e < 8; ++e) sm[r][e] += msk * f[e]; }
                    if (d == 0) {
#pragma unroll
                        for (int e = 0; e < 8; ++e) uc[r][e] = f[e]; } }
            }
#pragma unroll
            for (int r = 0; r < 4; ++r) { const int s = sf + r; const float inv = 1.0f / (float)(s + 1 < pw_ ? s + 1 : pw_);
                const u32x4 gt = *(const u32x4*)(P + (size_t)(tf + r) * 2048 + 512 + pc0);
                const float gf[8] = {bf_lo(gt.x), bf_hi(gt.x), bf_lo(gt.y), bf_hi(gt.y), bf_lo(gt.z), bf_hi(gt.z), bf_lo(gt.w), bf_hi(gt.w)};
                const float pbv[8] = {pb0.x, pb0.y, pb0.z, pb0.w, pb1.x, pb1.y, pb1.z, pb1.w}, psv[8] = {ps0.x, ps0.y, ps0.z, ps0.w, ps1.x, ps1.y, ps1.z, ps1.w};
                float y[8];
#pragma unroll
                for (int e = 0; e < 8; ++e) y[e] = (sm[r][e] * inv - uc[r][e] + pbv[e]) * psv[e] * gf[e];
                u32x4 w; w.x = cvt_pk_bf16(y[0], y[1]); w.y = cvt_pk_bf16(y[2], y[3]); w.z = cvt_pk_bf16(y[4], y[5]); w.w = cvt_pk_bf16(y[6], y[7]);
                *(u32x4*)(Y + (size_t)(tf + r) * DM + pc0) = w; }
        }
        __syncthreads();
        {
            f32x2 a[16];
#pragma unroll
            for (int r = 0; r < 16; ++r) a[r] = cb;
            const LAS unsigned* hp = (const LAS unsigned*)(Hs + (th * 16) * 1024 + cp * 4);
#pragma unroll
            for (int i = 0; i < 46; ++i) { const unsigned w = hp[i * 256]; const f32x2 v = (f32x2){bf_lo(w), bf_hi(w)};
#pragma unroll
                for (int r = 0; r < 16; ++r) { const int j = i - r; if (j >= 0 && j <= 30) a[r] += tw[j] * v; } }
#pragma unroll
            for (int r = 0; r < 16; ++r) *(LAS f32x2*)(Cs + (th * 16 + r) * 512 + 2 * cp) = a[r];
        }
        __syncthreads();
#pragma unroll
        for (int rr = 0; rr < 4; ++rr) { const int row = 4 * wave + rr;
            f32x4 v0 = *(const LAS f32x4*)(Cs + row * 512 + 4 * lane), v1 = *(const LAS f32x4*)(Cs + row * 512 + 256 + 4 * lane);
            const float mean = wave_sum((v0.x + v0.y) + (v0.z + v0.w) + (v1.x + v1.y) + (v1.z + v1.w)) * (1.0f / 512.0f);
            v0 = v0 - mean; v1 = v1 - mean;
            const float var = wave_sum((v0.x * v0.x + v0.y * v0.y) + (v0.z * v0.z + v0.w * v0.w) + (v1.x * v1.x + v1.y * v1.y) + (v1.z * v1.z + v1.w * v1.w)) * (1.0f / 512.0f);
            const float rstd = 1.0f / sqrtf(var + 1e-5f);
            v0 = v0 * rstd * lg0 + lb0; v1 = v1 * rstd * lg1 + lb1;
            u32x2 w0, w1; w0.x = cvt_pk_bf16(silu(v0.x), silu(v0.y)); w0.y = cvt_pk_bf16(silu(v0.z), silu(v0.w)); w1.x = cvt_pk_bf16(silu(v1.x), silu(v1.y)); w1.y = cvt_pk_bf16(silu(v1.z), silu(v1.w));
            bf16* o = HC + (size_t)(t0 + row) * WC; *(u32x2*)(o + 4 * lane) = w0; *(u32x2*)(o + 256 + 4 * lane) = w1; }
        __syncthreads();
    }
}

__device__ __forceinline__ void phase_final(const Params& p, int bid, int G) {
    const int tid = threadIdx.x, lane = tid & 63, wave = __builtin_amdgcn_readfirstlane(tid >> 6);
    const float* part = (const float*)(p.ws + WS_PART);
    const int gw = bid * 8 + wave, NGW = G * 8;
    f32x4 gv[4];
#pragma unroll
    for (int j = 0; j < 4; ++j) gv[j] = *((const f32x4*)p.final_g + lane + 64 * j);
    for (int m = gw; m < MTOK; m += NGW) {
        float s = lane < 16 ? part[((size_t)(lane >> 2) * MTOK + m) * 4 + (lane & 3)] : 0.f;
        s = wave_sum(s);
        const float r = 1.0f / sqrtf(s * (1.0f / DM) + 1e-6f);
        f32x4* o = (f32x4*)(p.out + (size_t)m * DM) + lane;
#pragma unroll
        for (int j = 0; j < 4; ++j) { const f32x4 v = o[64 * j]; o[64 * j] = v * r * gv[j]; }
    }
}

__global__ void __launch_bounds__(NTHR, 2) fwd_mega(Params p) {
    extern __shared__ __attribute__((aligned(16))) unsigned char lds_raw[];
    LAS unsigned char* lds = (LAS unsigned char*)lds_raw;
    const int bid = blockIdx.x, G = gridDim.x;
    const bf16* WinT = (const bf16*)(p.ws + WS_WIN); const bf16* PwT = (const bf16*)(p.ws + WS_PW); const bf16* WoutT = (const bf16*)(p.ws + WS_WOUT);
    const bf16* HN = (const bf16*)(p.ws + WS_HN); bf16* P = (bf16*)(p.ws + WS_P); const bf16* HC = (const bf16*)(p.ws + WS_HC); bf16* Y = (bf16*)(p.ws + WS_Y);
    float* part = (float*)(p.ws + WS_PART);

    volatile LAS unsigned* MISC = (volatile LAS unsigned*)(lds + MISC_OFF);
    if (threadIdx.x < 64) MISC[threadIdx.x] = 0u;
    __syncthreads();
    XcdBarrier bar = xcd_barrier_post((unsigned*)(p.ws + WS_BAR), MISC + 8);
#define GSYNC() xcd_barrier(bar)
    phase_prep(p, lds, bid, G);
    GSYNC();
    {
        pg8::Gemm g{HN, WinT, MTOK, DIN, DM}; pg8::StaticOrder S; S.init(MTOK, DIN, G, bid);
        pg8::EpiProj E{P};
        pg8::gemm_phase<pg8::EpiProj, pg8::StaticOrder, true, true>(lds, g, S, E);
    }
    GSYNC();
    phase_mixer(p, lds, bid, G);
    GSYNC();
    {
        pg8::Gemm g{HC, PwT, MTOK, WC, WC}; pg8::StaticOrder S; S.init(MTOK, WC, G, bid);
        pg8::EpiPw E{P, Y, p.pw_b};
        pg8::gemm_phase<pg8::EpiPw, pg8::StaticOrder, true, true>(lds, g, S, E);
    }
    GSYNC();
    {
        pg8::Gemm g{Y, WoutT, MTOK, DM, DM}; pg8::StaticOrder S; S.init(MTOK, DM, G, bid);
        pg8::EpiOut E{p.x, p.out, part};
        pg8::gemm_phase<pg8::EpiOut, pg8::StaticOrder, true, true>(lds, g, S, E);
    }
    GSYNC();
    phase_final(p, bid, G);
}

extern "C" void kernel_launch(void* const* d_in, const int* in_sizes, int n_in, void* d_out, int out_size, void* d_ws, size_t ws_size, hipStream_t stream) {
    static int grid_blocks = 0;
    if (grid_blocks == 0) {
        if (n_in != 14 || in_sizes[0] != MTOK * DM || out_size != MTOK * DM || ws_size < WS_END) { fprintf(stderr, "kernel_launch: unexpected shapes (n_in %d, ws %zu)\n", n_in, ws_size); grid_blocks = -1; return; }
        int dev = 0, cus = 0, per_cu = 0;
        (void)hipGetDevice(&dev); (void)hipDeviceGetAttribute(&cus, hipDeviceAttributeMultiprocessorCount, dev);
        if (hipFuncSetAttribute((const void*)fwd_mega, hipFuncAttributeMaxDynamicSharedMemorySize, LDS_BYTES) != hipSuccess) { fprintf(stderr, "kernel_launch: hipFuncSetAttribute failed\n"); grid_blocks = -1; return; }
        if (hipOccupancyMaxActiveBlocksPerMultiprocessor(&per_cu, (const void*)fwd_mega, NTHR, LDS_BYTES) != hipSuccess || per_cu < 1) { fprintf(stderr, "kernel_launch: occupancy query failed (%d)\n", per_cu); (void)hipGetLastError(); per_cu = 1; }
        if (per_cu > 1) per_cu = 1;
        grid_blocks = cus * per_cu;
    }
    if (grid_blocks < 0) return;
    Params p{};
    p.x = (const float*)d_in[0]; p.norm_g = (const float*)d_in[1]; p.w_in = (const float*)d_in[2]; p.pool_w = (const float*)d_in[3]; p.pool_b = (const float*)d_in[4];
    p.pool_scale = (const float*)d_in[5]; p.conv_dw = (const float*)d_in[6]; p.conv_b = (const float*)d_in[7]; p.ln_g = (const float*)d_in[8]; p.ln_b = (const float*)d_in[9];
    p.pw_w = (const float*)d_in[10]; p.pw_b = (const float*)d_in[11]; p.w_out = (const float*)d_in[12]; p.final_g = (const float*)d_in[13];
    p.out = (float*)d_out; p.ws = (unsigned char*)d_ws;
    if (hipMemsetAsync((char*)d_ws + WS_BAR, 0, 16384, stream) != hipSuccess) { fprintf(stderr, "kernel_launch: memset failed\n"); return; }
    hipLaunchKernelGGL(fwd_mega, dim3(grid_blocks), dim3(NTHR), LDS_BYTES, stream, p);
    const hipError_t e = hipPeekAtLastError();
    if (e != hipSuccess) fprintf(stderr, "kernel_launch: launch failed: %s (grid %d)\n", hipGetErrorString(e), grid_blocks);
}
```

```cpp
#include <hip/hip_runtime.h>
#include <cstdio>
#include <cstdint>
namespace pg8 {
#define PG8_LAS __attribute__((address_space(3)))
typedef unsigned short bf16_t;
typedef short bf16x8 __attribute__((ext_vector_type(8)));
typedef float f32x4 __attribute__((ext_vector_type(4)));
typedef unsigned u32x4 __attribute__((ext_vector_type(4)));
constexpr int BM = 256, BK = 64, HALF = 128, HTB = HALF * BK * 2  , STAGE_BYTES = 8 * HTB, NXCD = 8, WGM = 8;

__host__ __device__ __forceinline__ int lds_byte(int r, int c) { const int st = (r >> 4) * 2 + (c >> 5), rr = r & 15, cc = c & 31, ob = rr * 64 + cc * 2; return st * 1024 + (ob ^ (((ob >> 9) & 1) << 5)); }
__host__ __device__ __forceinline__ void stage_rc(int b, int& R, int& C) { const int st = b / 1024, sb = b % 1024, swz = sb ^ (((sb >> 9) & 1) << 5); R = (st >> 1) * 16 + swz / 64; C = (st & 1) * 32 + (swz % 64) / 2; }
__host__ __device__ __forceinline__ int perm32(int rho) { const int n = rho >> 4, i = rho & 15; return 8 * (i >> 2) + 4 * n + (i & 3); }

struct Unit { int pm, pn; };
struct Gemm { const bf16_t* A; const bf16_t* Bt; int M, N, K; };

struct StaticOrder {
    int nM, nN, nwg, G, c;
    __host__ __device__ void init(int M, int N, int G_, int c_) { nM = M / BM; nN = N / BM; nwg = nM * nN; G = G_; c = c_; }
    __host__ __device__ bool next(int i, Unit& u) const {
        const long L = (long)i * G + c; if (L >= nwg) return false;
        int wgid = (int)L; { const int q = nwg / NXCD, r = nwg % NXCD, xcd = wgid % NXCD, off = wgid / NXCD; wgid = (xcd < r ? xcd * (q + 1) : r * (q + 1) + (xcd - r) * q) + off; }
        const int nig = WGM * nN, gid = wgid / nig, fm = gid * WGM, gsz = (nM - fm) < WGM ? (nM - fm) : WGM;
        u.pm = fm + ((wgid % nig) % gsz); u.pn = (wgid % nig) / gsz; return true;
    }
    __device__ __forceinline__ void a_ready(const Unit&) const {}
    __device__ __forceinline__ void done(const Unit&) const {}
};
__device__ __forceinline__ unsigned cvt_pk_bf16(float lo, float hi) { unsigned r; asm volatile("v_cvt_pk_bf16_f32 %0, %1, %2" : "=v"(r) : "v"(lo), "v"(hi)); return r; }
typedef float f32x2 __attribute__((ext_vector_type(2)));

__device__ __forceinline__ float sigm(float v) { return __builtin_amdgcn_rcpf(1.0f + __expf(-v)); }
__device__ __forceinline__ float silu(float v) { return v * sigm(v); }
struct EpiProj {
    static constexpr bool PERM = true, AFTER_DRAIN = false;
    bf16_t* P;
    __device__ __forceinline__ void operator()(const f32x4 (&acc)[2][2][4][2], const Unit& u, int wr, int wc, int fr, int fq) const {
        const int row0 = u.pm * BM + wr * 64 + fr; const int pn = u.pn;
        if (pn >= 4 && pn < 8) {
            const int col0 = 1024 + 128 * (pn - 4) + wc * 32 + 8 * fq;
#pragma unroll
            for (int ai = 0; ai < 2; ++ai)
#pragma unroll
                for (int m = 0; m < 4; ++m) { bf16_t* rowp = P + (size_t)(row0 + ai * HALF + m * 16) * 2048 + col0;
                    const f32x4 v0 = acc[ai][0][m][0], v1 = acc[ai][0][m][1], g0 = acc[ai][1][m][0], g1 = acc[ai][1][m][1];
                    u32x4 w; w.x = cvt_pk_bf16(v0[0] * sigm(g0[0]), v0[1] * sigm(g0[1])); w.y = cvt_pk_bf16(v0[2] * sigm(g0[2]), v0[3] * sigm(g0[3]));
                    w.z = cvt_pk_bf16(v1[0] * sigm(g1[0]), v1[1] * sigm(g1[1])); w.w = cvt_pk_bf16(v1[2] * sigm(g1[2]), v1[3] * sigm(g1[3]));
                    *(u32x4*)rowp = w; }
        } else {
            const int colbase = pn < 4 ? 256 * pn : 1536 + 256 * (pn - 8); const bool act = pn >= 2;
            const int col0 = colbase + wc * 32 + 8 * fq;
#pragma unroll
            for (int ai = 0; ai < 2; ++ai)
#pragma unroll
                for (int m = 0; m < 4; ++m) { bf16_t* rowp = P + (size_t)(row0 + ai * HALF + m * 16) * 2048 + col0;
#pragma unroll
                    for (int bj = 0; bj < 2; ++bj) { f32x4 v0 = acc[ai][bj][m][0], v1 = acc[ai][bj][m][1];
                        if (act) {
#pragma unroll
                            for (int j = 0; j < 4; ++j) { v0[j] = silu(v0[j]); v1[j] = silu(v1[j]); } }
                        u32x4 w; w.x = cvt_pk_bf16(v0[0], v0[1]); w.y = cvt_pk_bf16(v0[2], v0[3]); w.z = cvt_pk_bf16(v1[0], v1[1]); w.w = cvt_pk_bf16(v1[2], v1[3]);
                        *(u32x4*)(rowp + bj * HALF) = w; } }
        }
    }
};
__device__ __forceinline__ float bf_lo(unsigned w) { return __uint_as_float(w << 16); }
__device__ __forceinline__ float bf_hi(unsigned w) { return __uint_as_float(w & 0xffff0000u); }
struct EpiPw {
    static constexpr bool PERM = true, AFTER_DRAIN = false;
    const bf16_t* P; bf16_t* Y; const float* bias;
    __device__ __forceinline__ void operator()(const f32x4 (&acc)[2][2][4][2], const Unit& u, int wr, int wc, int fr, int fq) const {
        const int row0 = u.pm * BM + wr * 64 + fr; const int col0 = u.pn * BM + wc * 32 + 8 * fq;
        f32x4 bv[2][2];
#pragma unroll
        for (int bj = 0; bj < 2; ++bj)
#pragma unroll
            for (int n = 0; n < 2; ++n) bv[bj][n] = *(const f32x4*)(bias + col0 + bj * HALF + 4 * n);
#pragma unroll
        for (int ai = 0; ai < 2; ++ai)
#pragma unroll
            for (int m = 0; m < 4; ++m) { const size_t row = (size_t)(row0 + ai * HALF + m * 16);
#pragma unroll
                for (int bj = 0; bj < 2; ++bj) { const u32x4 gt = *(const u32x4*)(P + row * 2048 + 1536 + col0 + bj * HALF);
                    const f32x4 v0 = acc[ai][bj][m][0] + bv[bj][0], v1 = acc[ai][bj][m][1] + bv[bj][1];
                    u32x4 w; w.x = cvt_pk_bf16(v0[0] * bf_lo(gt.x), v0[1] * bf_hi(gt.x)); w.y = cvt_pk_bf16(v0[2] * bf_lo(gt.y), v0[3] * bf_hi(gt.y));
                    w.z = cvt_pk_bf16(v1[0] * bf_lo(gt.z), v1[1] * bf_hi(gt.z)); w.w = cvt_pk_bf16(v1[2] * bf_lo(gt.w), v1[3] * bf_hi(gt.w));
                    *(u32x4*)(Y + row * 1024 + 512 + col0 + bj * HALF) = w; } }
    }
};
struct EpiDelta {
    static constexpr bool PERM = true, AFTER_DRAIN = false;
    bf16_t* O;
    __device__ __forceinline__ void operator()(const f32x4 (&acc)[2][2][4][2], const Unit& u, int wr, int wc, int fr, int fq) const {
        const int row0 = u.pm * BM + wr * 64 + fr; const int col0 = u.pn * BM + wc * 32 + 8 * fq;
#pragma unroll
        for (int ai = 0; ai < 2; ++ai)
#pragma unroll
            for (int m = 0; m < 4; ++m) { bf16_t* rowp = O + (size_t)(row0 + ai * HALF + m * 16) * 1024 + col0;
#pragma unroll
                for (int bj = 0; bj < 2; ++bj) { const f32x4 v0 = acc[ai][bj][m][0], v1 = acc[ai][bj][m][1];
                    u32x4 w; w.x = cvt_pk_bf16(v0[0], v0[1]); w.y = cvt_pk_bf16(v0[2], v0[3]); w.z = cvt_pk_bf16(v1[0], v1[1]); w.w = cvt_pk_bf16(v1[2], v1[3]);
                    *(u32x4*)(rowp + bj * HALF) = w; } }
    }
};

template <class Epi, class Sched, bool ALIGN_EPI = false, bool SP2 = false>
__device__ __forceinline__ void gemm_phase(PG8_LAS unsigned char* lds, const Gemm g, const Sched& S, const Epi& E) {
    int tid_ = threadIdx.x; asm volatile("" : "+v"(tid_));
    const int tid = tid_, wid = __builtin_amdgcn_readfirstlane(tid >> 6), lane = tid & 63, wr = wid >> 2, wc = wid & 3, fr = lane & 15, fq = lane >> 4;
    const int K = g.K, nt = K / BK;
    unsigned voffA[2], voffB[2];
#pragma unroll
    for (int i = 0; i < 2; ++i) { int R, C; stage_rc(tid * 16 + i * 8192, R, C); const int Rb = Epi::PERM ? ((R & ~31) + perm32(R & 31)) : R;
        voffA[i] = (unsigned)(R * K + C) * 2u; voffB[i] = (unsigned)(Rb * K + C) * 2u; }
    const size_t kstep = (size_t)(BK * 2);
    const size_t hstep = (size_t)HALF * K * 2;
    const size_t tstep = 2 * hstep;
    const unsigned ldsw = (unsigned)wid * 1024u;
    const int aoff = lds_byte(wr * 64 + fr, fq * 8), boff = lds_byte(wc * 32 + fr, fq * 8);
#define PG8_SA(b, h) (((b) * 2 + (h)) * HTB)
#define PG8_SB(b, h) ((4 + (b) * 2 + (h)) * HTB)
#define PG8_STAGE(bufoff, gbase, voff) do { _Pragma("unroll") for (int _i = 0; _i < 2; ++_i) \
        __builtin_amdgcn_global_load_lds((const unsigned*)((const char*)(gbase) + (voff)[_i]), (PG8_LAS unsigned*)(lds + (bufoff) + ldsw + _i * 8192), 16, 0, 0); } while (0)
#define PG8_LDA(dst, b, h) do { _Pragma("unroll") for (int m = 0; m < 4; ++m) _Pragma("unroll") for (int k = 0; k < 2; ++k) dst[m][k] = *(const PG8_LAS bf16x8*)(lds + PG8_SA(b, h) + aoff + m * 2048 + k * 1024); } while (0)
#define PG8_LDB(dst, b, h) do { _Pragma("unroll") for (int n = 0; n < 2; ++n) _Pragma("unroll") for (int k = 0; k < 2; ++k) dst[n][k] = *(const PG8_LAS bf16x8*)(lds + PG8_SB(b, h) + boff + n * 2048 + k * 1024); } while (0)
#define PG8_MMA(ai, bj, At, Bt) do { __builtin_amdgcn_s_setprio(1); _Pragma("unroll") for (int m = 0; m < 4; ++m) _Pragma("unroll") for (int n = 0; n < 2; ++n) _Pragma("unroll") for (int k = 0; k < 2; ++k) \
        acc[ai][bj][m][n] = __builtin_amdgcn_mfma_f32_16x16x32_bf16(Bt[n][k], At[m][k], acc[ai][bj][m][n], 0, 0, 0); __builtin_amdgcn_s_setprio(0); } while (0)
#define PG8_WAIT_V(n) asm volatile("s_waitcnt vmcnt(" #n ")" ::: "memory")
#define PG8_WAIT_L(n) asm volatile("s_waitcnt lgkmcnt(" #n ")" ::: "memory")
#define PG8_BAR __builtin_amdgcn_s_barrier()
#define PG8_SCHED __builtin_amdgcn_sched_barrier(0)
    Unit cur, nxt; int ui = 0;
    if (!S.next(0, cur)) return;
    f32x4 acc[2][2][4][2];
#pragma unroll
    for (int a = 0; a < 2; ++a)
#pragma unroll
        for (int b = 0; b < 2; ++b)
#pragma unroll
            for (int m = 0; m < 4; ++m)
#pragma unroll
                for (int n = 0; n < 2; ++n) acc[a][b][m][n] = (f32x4){0.f, 0.f, 0.f, 0.f};
    bf16x8 At[4][2], B0[2][2], B1[2][2];
    const char* cA = (const char*)g.A + (size_t)cur.pm * tstep; const char* cB = (const char*)g.Bt + (size_t)cur.pn * tstep;
    S.a_ready(cur);
    if constexpr (SP2) {
        PG8_STAGE(PG8_SB(0, 0), cB, voffB); PG8_STAGE(PG8_SB(0, 1), cB + hstep, voffB); PG8_STAGE(PG8_SA(0, 0), cA, voffA); PG8_STAGE(PG8_SA(0, 1), cA + hstep, voffA);
        if (wr == 1) PG8_BAR;
        PG8_WAIT_V(2); PG8_BAR;
        PG8_STAGE(PG8_SB(1, 0), cB + kstep, voffB); PG8_STAGE(PG8_SA(1, 0), cA + kstep, voffA); PG8_STAGE(PG8_SB(1, 1), cB + hstep + kstep, voffB);
        PG8_WAIT_V(6); PG8_BAR;
    } else {
        PG8_STAGE(PG8_SB(0, 0), cB, voffB); PG8_STAGE(PG8_SA(0, 0), cA, voffA); PG8_STAGE(PG8_SB(0, 1), cB + hstep, voffB); PG8_STAGE(PG8_SA(0, 1), cA + hstep, voffA);
        if (wr == 1) PG8_BAR;
        PG8_WAIT_V(4); PG8_BAR;
        PG8_STAGE(PG8_SB(1, 0), cB + kstep, voffB); PG8_STAGE(PG8_SA(1, 0), cA + kstep, voffA); PG8_STAGE(PG8_SB(1, 1), cB + hstep + kstep, voffB);
        PG8_WAIT_V(6); PG8_BAR;
    }
    for (;;) {
        const bool has_next = S.next(ui + 1, nxt);
        const char* nA = has_next ? (const char*)g.A + (size_t)nxt.pm * tstep : cA; const char* nB = has_next ? (const char*)g.Bt + (size_t)nxt.pn * tstep : cB;
        for (int t = 0; t < nt; t += 2) {
            const bool last = (t == nt - 2);
            const char* a1 = cA + (size_t)(t + 1) * kstep;
            const char* a2 = last ? nA : cA + (size_t)(t + 2) * kstep; const char* b2 = last ? nB : cB + (size_t)(t + 2) * kstep;
            const char* a3 = a2 + kstep; const char* b3 = b2 + kstep;
            if (last && has_next) S.a_ready(nxt);
            if constexpr (SP2) {
            PG8_LDB(B0, 0, 0); PG8_LDB(B1, 0, 1); PG8_SCHED; PG8_LDA(At, 0, 0); PG8_STAGE(PG8_SA(1, 1), a1 + hstep, voffA);
            PG8_WAIT_V(8); PG8_WAIT_L(0); PG8_BAR; PG8_MMA(0, 0, At, B0); PG8_MMA(0, 1, At, B1); PG8_BAR; PG8_SCHED;
            PG8_LDA(At, 0, 1); PG8_STAGE(PG8_SB(0, 0), b2, voffB); PG8_STAGE(PG8_SB(0, 1), b2 + hstep, voffB); PG8_STAGE(PG8_SA(0, 0), a2, voffA);
            PG8_WAIT_V(8); PG8_WAIT_L(0); PG8_BAR; PG8_MMA(1, 0, At, B0); PG8_MMA(1, 1, At, B1); PG8_BAR; PG8_SCHED;
            PG8_LDB(B0, 1, 0); PG8_LDB(B1, 1, 1); PG8_SCHED; PG8_LDA(At, 1, 0); PG8_STAGE(PG8_SA(0, 1), a2 + hstep, voffA);
            PG8_WAIT_V(8); PG8_WAIT_L(0); PG8_BAR; PG8_MMA(0, 0, At, B0); PG8_MMA(0, 1, At, B1); PG8_BAR; PG8_SCHED;
            PG8_LDA(At, 1, 1); PG8_STAGE(PG8_SB(1, 0), b3, voffB); PG8_STAGE(PG8_SB(1, 1), b3 + hstep, voffB); PG8_STAGE(PG8_SA(1, 0), a3, voffA);
            PG8_WAIT_V(8); PG8_WAIT_L(0); PG8_BAR; PG8_MMA(1, 0, At, B0); PG8_MMA(1, 1, At, B1); PG8_BAR; PG8_SCHED;
            } else {
            PG8_LDB(B0, 0, 0); PG8_SCHED; PG8_LDA(At, 0, 0); PG8_STAGE(PG8_SA(1, 1), a1 + hstep, voffA);
            PG8_WAIT_L(8); PG8_BAR; PG8_WAIT_L(0); PG8_MMA(0, 0, At, B0); PG8_BAR; PG8_SCHED;
            PG8_LDB(B1, 0, 1); PG8_STAGE(PG8_SB(0, 0), b2, voffB);
            PG8_BAR; PG8_WAIT_L(0); PG8_MMA(0, 1, At, B1); PG8_BAR;
            PG8_LDA(At, 0, 1); PG8_STAGE(PG8_SA(0, 0), a2, voffA);
            PG8_BAR; PG8_WAIT_L(0); PG8_MMA(1, 0, At, B0); PG8_BAR; PG8_SCHED;
            PG8_STAGE(PG8_SB(0, 1), b2 + hstep, voffB);
            PG8_WAIT_V(6); PG8_BAR; PG8_MMA(1, 1, At, B1); PG8_BAR;
            PG8_LDB(B0, 1, 0); PG8_SCHED; PG8_LDA(At, 1, 0); PG8_STAGE(PG8_SA(0, 1), a2 + hstep, voffA);
            PG8_WAIT_L(8); PG8_BAR; PG8_WAIT_L(0); PG8_MMA(0, 0, At, B0); PG8_BAR; PG8_SCHED;
            PG8_LDB(B1, 1, 1); PG8_STAGE(PG8_SB(1, 0), b3, voffB);
            PG8_BAR; PG8_WAIT_L(0); PG8_MMA(0, 1, At, B1); PG8_BAR;
            PG8_LDA(At, 1, 1); PG8_STAGE(PG8_SA(1, 0), a3, voffA);
            PG8_BAR; PG8_WAIT_L(0); PG8_MMA(1, 0, At, B0); PG8_BAR; PG8_SCHED;
            PG8_STAGE(PG8_SB(1, 1), b3 + hstep, voffB);
            PG8_WAIT_V(6); PG8_BAR; PG8_MMA(1, 1, At, B1); PG8_BAR;
            }
        }
        if constexpr (ALIGN_EPI) { if (wr == 0) PG8_BAR; }
        if constexpr (!Epi::AFTER_DRAIN) { E(acc, cur, wr, wc, fr, fq); S.done(cur); }
        if (!has_next) break;
#pragma unroll
        for (int a = 0; a < 2; ++a)
#pragma unroll
            for (int b = 0; b < 2; ++b)
#pragma unroll
                for (int m = 0; m < 4; ++m)
#pragma unroll
                    for (int n = 0; n < 2; ++n) acc[a][b][m][n] = (f32x4){0.f, 0.f, 0.f, 0.f};
        cur = nxt; cA = nA; cB = nB; ++ui;
        if constexpr (ALIGN_EPI) { if (wr == 1) PG8_BAR; }
    }
    PG8_WAIT_V(0);
    if constexpr (!ALIGN_EPI) { if (wr == 0) PG8_BAR; }
    PG8_BAR;
    if constexpr (Epi::AFTER_DRAIN) { E.fused(acc, cur, wr, wc, fr, fq, lds, wid, lane); S.done(cur); }
#undef PG8_SA
#undef PG8_SB
#undef PG8_STAGE
#undef PG8_LDA
#undef PG8_LDB
#undef PG8_MMA
#undef PG8_WAIT_V
#undef PG8_WAIT_L
#undef PG8_BAR
#undef PG8_SCHED
}
}

constexpr int MTOK = 16 * 2048, SEQ = 2048, DM = 1024, DIN = 2560, WP = 512, WC = 512;
constexpr int MISC_OFF = 131072, LDS_BYTES = 131072 + 256, NTHR = 512;
constexpr size_t WS_WIN = 0, WS_PW = WS_WIN + (size_t)DIN * DM * 2, WS_WOUT = WS_PW + (size_t)WC * WC * 2, WS_HN = WS_WOUT + (size_t)DM * DM * 2,
                 WS_P = WS_HN + (size_t)MTOK * DM * 2, WS_HC = WS_P + (size_t)MTOK * 2048 * 2, WS_Y = WS_HC + (size_t)MTOK * WC * 2, WS_PART = WS_Y + (size_t)MTOK * DM * 2,
                 WS_BAR = WS_PART + (size_t)MTOK * 16 * 4, WS_DELTA = WS_HN  , WS_END = WS_BAR + 16384;
#define LAS __attribute__((address_space(3)))
typedef unsigned short bf16;
typedef float f32x4 __attribute__((ext_vector_type(4)));
typedef float f32x2 __attribute__((ext_vector_type(2)));
typedef unsigned u32x4 __attribute__((ext_vector_type(4)));
typedef unsigned u32x2 __attribute__((ext_vector_type(2)));
#define LDS_WAIT() asm volatile("s_waitcnt lgkmcnt(0)" ::: "memory")
using pg8::cvt_pk_bf16; using pg8::silu; using pg8::bf_lo; using pg8::bf_hi;

#define RLX_AGENT __ATOMIC_RELAXED, __HIP_MEMORY_SCOPE_AGENT
#define XB_TMO      128
#define XB_XCNT(j)  (256  + 64 * (j))
#define XB_XSUB(j)  (1280 + 64 * (j))
#define XB_XGEN(j)  (2304 + 64 * (j))
#define XB_TOP      3328
#define XB_TOPGEN   3392
#define XCD_BAR_WORDS 3456
#define XB_SPIN_CAP (1u << 18)

__device__ __forceinline__ unsigned xb_ld(unsigned* p)              { return __hip_atomic_load(p, __ATOMIC_RELAXED, __HIP_MEMORY_SCOPE_AGENT); }
__device__ __forceinline__ unsigned xb_add(unsigned* p, unsigned v) { return __hip_atomic_fetch_add(p, v, __ATOMIC_RELAXED, __HIP_MEMORY_SCOPE_AGENT); }
__device__ __forceinline__ unsigned xb_xcc_id() { return (unsigned)__builtin_amdgcn_s_getreg((3 << 11) | 20) & 0xFu; }
#define XB_SPIN(cond, bar) do { unsigned _sp = 0; while (cond) { __builtin_amdgcn_s_sleep(1); \
    if ((++_sp & 255u) == 0u) { if (xb_ld(&(bar)[XB_TMO])) break; if (_sp > XB_SPIN_CAP) { atomicAdd(&(bar)[XB_TMO], 1u); break; } } } } while (0)

struct XcdBarrier {
    unsigned* bar; unsigned x;
    volatile LAS unsigned* st;
};

__device__ __forceinline__ XcdBarrier xcd_barrier_post(unsigned* bar, volatile LAS unsigned* st) {
    XcdBarrier b; b.bar = bar; b.x = xb_xcc_id(); b.st = st;
    if (threadIdx.x == 0) (void)xb_add(&bar[XB_XCNT(b.x)], 1u);
    return b;
}
__device__ __forceinline__ void xcd_barrier_complete(unsigned* bar, unsigned x, unsigned& nloc, unsigned& nx) {
    const unsigned G = gridDim.x * gridDim.y * gridDim.z;
    unsigned sum, cnt, mine, sp = 0u;
    for (;;) {
        sum = 0u; cnt = 0u; mine = 0u;
#pragma unroll
        for (unsigned j = 0; j < 16; ++j) { const unsigned c = xb_ld(&bar[XB_XCNT(j)]); sum += c; cnt += (c > 0u) ? 1u : 0u; mine = (j == x) ? c : mine; }
        if (sum == G) break;
        __builtin_amdgcn_s_sleep(1);
        if ((++sp & 255u) == 0u) { if (xb_ld(&bar[XB_TMO])) break; if (sp > XB_SPIN_CAP) { atomicAdd(&bar[XB_TMO], 1u); break; } }
    }
    nloc = mine > 0u ? mine : 1u; nx = cnt > 0u ? cnt : 1u;
}

__device__ __forceinline__ void xcd_barrier(const XcdBarrier& b) {
    asm volatile("s_waitcnt vmcnt(0)" ::: "memory");
    __syncthreads();
    if (threadIdx.x == 0) {
        unsigned* bar = b.bar;
        __builtin_amdgcn_s_waitcnt(0);
        unsigned nloc = b.st[0], nx = b.st[1];
        if (nloc == 0u) { xcd_barrier_complete(bar, b.x, nloc, nx); b.st[0] = nloc; b.st[1] = nx; }
        const unsigned old = xb_add(&bar[XB_XSUB(b.x)], 1u);
        const unsigned gen = old / nloc;
        if (old + 1u == (gen + 1u) * nloc) {
            __builtin_amdgcn_fence(__ATOMIC_RELEASE, "agent");
            asm volatile("s_waitcnt vmcnt(0)" ::: "memory");
            const unsigned og = xb_add(&bar[XB_TOP], 1u);
            const unsigned tg = og / nx;
            if (og + 1u == (tg + 1u) * nx) xb_add(&bar[XB_TOPGEN], 1u);
            else XB_SPIN(xb_ld(&bar[XB_TOPGEN]) == tg, bar);
            __builtin_amdgcn_fence(__ATOMIC_ACQUIRE, "agent");
            xb_add(&bar[XB_XGEN(b.x)], 1u);
            asm volatile("s_waitcnt vmcnt(0)" ::: "memory");
        } else {
            XB_SPIN(xb_ld(&bar[XB_XGEN(b.x)]) == gen, bar);
            __builtin_amdgcn_fence(__ATOMIC_ACQUIRE, "agent");
            asm volatile("s_waitcnt vmcnt(0)" ::: "memory");
        }
    }
    __syncthreads();
}

struct Params {
    const float *x, *norm_g, *w_in, *pool_w, *pool_b, *pool_scale, *conv_dw, *conv_b, *ln_g, *ln_b, *pw_w, *pw_b, *w_out, *final_g;
    float* out; unsigned char* ws;
};

__device__ __forceinline__ float wave_sum(float v) {
#pragma unroll
    for (int o = 1; o < 64; o <<= 1) v += __shfl_xor(v, o);
    return v;
}
__device__ __forceinline__ void transpose_item(const float* W, int ldw, int scol0, int k0, bf16* WT, int ldt, int drow0, LAS float* scr, int lane) {
#pragma unroll 8
    for (int i = 0; i < 32; ++i) { const int kk = 2 * i + (lane >> 5); scr[kk * 33 + (lane & 31)] = W[(size_t)(k0 + kk) * ldw + scol0 + (lane & 31)]; }
    LDS_WAIT();
    const int c = lane & 7;
#pragma unroll
    for (int j = 0; j < 4; ++j) { const int n = (lane >> 3) + 8 * j; const LAS float* s = scr + (8 * c) * 33 + n;
        u32x4 o; o.x = cvt_pk_bf16(s[0 * 33], s[1 * 33]); o.y = cvt_pk_bf16(s[2 * 33], s[3 * 33]); o.z = cvt_pk_bf16(s[4 * 33], s[5 * 33]); o.w = cvt_pk_bf16(s[6 * 33], s[7 * 33]);
        *(u32x4*)(WT + (size_t)(drow0 + n) * ldt + k0 + 8 * c) = o; }
    LDS_WAIT();
}
__device__ __forceinline__ void poolfold_item(const float* w_in, const float* pool_w, bf16* WinT, int g, int k0, LAS float* scr, int lane) {
#pragma unroll
    for (int kk = 0; kk < 8; ++kk) { const f32x2 v = *(const f32x2*)(w_in + (size_t)(k0 + kk) * DIN + 128 * g + 2 * lane); *(LAS f32x2*)(scr + kk * 128 + 2 * lane) = v; }
    LDS_WAIT();
    float acc[8][2];
#pragma unroll
    for (int kk = 0; kk < 8; ++kk) { acc[kk][0] = 0.f; acc[kk][1] = 0.f; }
    const float* pw = pool_w + (size_t)g * 128 * 128 + lane;
#pragma unroll 2
    for (int c4 = 0; c4 < 32; ++c4) {
        float p[4][2];
#pragma unroll
        for (int cc = 0; cc < 4; ++cc) { p[cc][0] = pw[(4 * c4 + cc) * 128]; p[cc][1] = pw[(4 * c4 + cc) * 128 + 64]; }
#pragma unroll
        for (int kk = 0; kk < 8; ++kk) { const f32x4 wv = *(const LAS f32x4*)(scr + kk * 128 + 4 * c4);
#pragma unroll
            for (int cc = 0; cc < 4; ++cc) { acc[kk][0] += wv[cc] * p[cc][0]; acc[kk][1] += wv[cc] * p[cc][1]; } }
    }
#pragma unroll
    for (int h = 0; h < 2; ++h) { u32x4 o; o.x = cvt_pk_bf16(acc[0][h], acc[1][h]); o.y = cvt_pk_bf16(acc[2][h], acc[3][h]); o.z = cvt_pk_bf16(acc[4][h], acc[5][h]); o.w = cvt_pk_bf16(acc[6][h], acc[7][h]);
        *(u32x4*)(WinT + (size_t)(128 * g + lane + 64 * h) * DM + k0) = o; }
    LDS_WAIT();
}

__device__ __forceinline__ void phase_prep(const Params& p, LAS unsigned char* lds, int bid, int G) {
    int tid_ = threadIdx.x; asm volatile("" : "+v"(tid_)); const int tid = tid_, lane = tid & 63, wave = __builtin_amdgcn_readfirstlane(tid >> 6);
    LAS float* scr = (LAS float*)(lds + wave * 8704);
    bf16* WinT = (bf16*)(p.ws + WS_WIN); bf16* PwT = (bf16*)(p.ws + WS_PW); bf16* WoutT = (bf16*)(p.ws + WS_WOUT); bf16* HN = (bf16*)(p.ws + WS_HN);
    const int gw = bid * 8 + wave, NGW = G * 8;
    for (int t = gw; t < 2176; t += NGW) {
        if (t < 512) { poolfold_item(p.w_in, p.pool_w, WinT, t >> 7, 8 * (t & 127), scr, lane); }
        else if (t < 1536) { const int it = t - 512, kb = it >> 6, nb = it & 63, n = 512 + 32 * nb; int scol;
            if (n < 1024 || n >= 2048) scol = n; else { const int q = (n - 1024) >> 8, r = (n - 1024) & 255; scol = r < 128 ? 1024 + 128 * q + r : 1536 + 128 * q + (r - 128); }
            transpose_item(p.w_in, DIN, scol, 64 * kb, WinT, DM, n, scr, lane); }
        else if (t < 1664) { const int it = t - 1536, kb = it >> 4, nb = it & 15; transpose_item(p.pw_w, WC, 32 * nb, 64 * kb, PwT, WC, 32 * nb, scr, lane); }
        else { const int it = t - 1664, kb = it >> 5, nb = it & 31; transpose_item(p.w_out, DM, 32 * nb, 64 * kb, WoutT, DM, 32 * nb, scr, lane); }
    }
    f32x4 gv[4];
#pragma unroll
    for (int j = 0; j < 4; ++j) gv[j] = *((const f32x4*)p.norm_g + lane + 64 * j);
    for (int m = gw; m < MTOK; m += NGW) {
        const f32x4* xr = (const f32x4*)(p.x + (size_t)m * DM) + lane; f32x4 v[4]; float s = 0.f;
#pragma unroll
        for (int j = 0; j < 4; ++j) { v[j] = xr[64 * j]; s += (v[j].x * v[j].x + v[j].y * v[j].y) + (v[j].z * v[j].z + v[j].w * v[j].w); }
        const float r = 1.0f / sqrtf(wave_sum(s) * (1.0f / DM) + 1e-6f);
        u32x2* o8 = (u32x2*)(HN + (size_t)m * DM) + lane;
#pragma unroll
        for (int j = 0; j < 4; ++j) { const f32x4 y = v[j] * r * gv[j]; u32x2 w; w.x = cvt_pk_bf16(y.x, y.y); w.y = cvt_pk_bf16(y.z, y.w); o8[64 * j] = w; }
    }
}

__device__ __forceinline__ void mixer_load_h(const bf16* P, int tile, int wave, int lane, u32x4 (&hv)[8]) {
    const int t0 = tile * 32, s0 = t0 & (SEQ - 1);
#pragma unroll
    for (int k = 0; k < 8; ++k) { const int r = wave + 8 * k; const bool ok = (s0 - 30 + r >= 0) && (r < 62);
        const u32x4 v = *(const u32x4*)(P + (size_t)(ok ? t0 - 30 + r : t0) * 2048 + 1024 + lane * 8);
        hv[k] = ok ? v : (u32x4){0u, 0u, 0u, 0u}; }
}
__device__ __forceinline__ void phase_mixer(const Params& p, LAS unsigned char* lds, int bid, int G) {
    int tid_ = threadIdx.x; asm volatile("" : "+v"(tid_)); const int tid = tid_, lane = tid & 63, wave = __builtin_amdgcn_readfirstlane(tid >> 6);
    const bf16* P = (const bf16*)(p.ws + WS_P); bf16* HC = (bf16*)(p.ws + WS_HC); bf16* Y = (bf16*)(p.ws + WS_Y);
    LAS unsigned char* Hs = lds;
    LAS float* Cs = (LAS float*)(lds + 62 * 1024);
    const int cp = tid & 255, th = tid >> 8;
    const int pg = lane >> 4, pw_ = 2 << pg, pc0 = 8 * lane;
    const f32x4 pb0 = *(const f32x4*)(p.pool_b + pc0), pb1 = *(const f32x4*)(p.pool_b + pc0 + 4), ps0 = *(const f32x4*)(p.pool_scale + pc0), ps1 = *(const f32x4*)(p.pool_scale + pc0 + 4);
    const f32x4 lg0 = *(const f32x4*)(p.ln_g + 4 * lane), lg1 = *(const f32x4*)(p.ln_g + 256 + 4 * lane), lb0 = *(const f32x4*)(p.ln_b + 4 * lane), lb1 = *(const f32x4*)(p.ln_b + 256 + 4 * lane);
    const f32x2 cb = *(const f32x2*)(p.conv_b + 2 * cp);
    const int NT = MTOK / 32;
    u32x4 hv[8];
    if (bid < NT) mixer_load_h(P, bid, wave, lane, hv);
    for (int tile = bid; tile < NT; tile += G) {
        const int t0 = tile * 32, s0 = t0 & (SEQ - 1);
#pragma unroll
        for (int k = 0; k < 8; ++k) { const int r = wave + 8 * k; if (r < 62) *(LAS u32x4*)(Hs + r * 1024 + lane * 16) = hv[k]; }
        __syncthreads();
        {
            f32x2 tw[31];
#pragma unroll
            for (int j = 0; j < 31; ++j) tw[j] = *(const f32x2*)(p.conv_dw + j * WC + 2 * cp);
            f32x2 a[16];
#pragma unroll
            for (int r = 0; r < 16; ++r) a[r] = cb;
            const LAS unsigned* hp = (const LAS unsigned*)(Hs + (th * 16) * 1024 + cp * 4);
#pragma unroll
            for (int i = 0; i < 46; ++i) { const unsigned w = hp[i * 256]; const f32x2 v = (f32x2){bf_lo(w), bf_hi(w)};
#pragma unroll
                for (int r = 0; r < 16; ++r) { const int j = i - r; if (j >= 0 && j <= 30) a[r] += tw[j] * v; } }
#pragma unroll
            for (int r = 0; r < 16; ++r) *(LAS f32x2*)(Cs + (th * 16 + r) * 512 + 2 * cp) = a[r];
        }
        __syncthreads();
        {
            const int tf = t0 + 4 * wave, sf = s0 + 4 * wave;
            float sm[4][8], inv[4];
#pragma unroll
            for (int r = 0; r < 4; ++r) { const int s = sf + r; inv[r] = 1.0f / (float)(s + 1 < pw_ ? s + 1 : pw_);
#pragma unroll
                for (int e = 0; e < 8; ++e) sm[r][e] = 0.f; }
            u32x4 gt[4];
#pragma unroll
            for (int r = 0; r < 4; ++r) gt[r] = *(const u32x4*)(P + (size_t)(tf + r) * 2048 + 512 + pc0);
#pragma unroll
            for (int j = 0; j < 19; ++j) {
                const bool okr = sf - 15 + j >= 0;
                const u32x4 v = *(const u32x4*)(P + (size_t)(okr ? tf - 15 + j : tf) * 2048 + pc0);
                const float f[8] = {bf_lo(v.x), bf_hi(v.x), bf_lo(v.y), bf_hi(v.y), bf_lo(v.z), bf_hi(v.z), bf_lo(v.w), bf_hi(v.w)};
#pragma unroll
                for (int r = 0; r < 4; ++r) { const int d = 15 + r - j;
                    if (d >= 0 && d < 16) { float wgt = (okr && d < pw_) ? inv[r] : 0.f; if (d == 0) wgt -= 1.0f;
#pragma unroll
                        for (int e = 0; e < 8; ++e) sm[r][e] += wgt * f[e]; } }
            }
            const float pbv[8] = {pb0.x, pb0.y, pb0.z, pb0.w, pb1.x, pb1.y, pb1.z, pb1.w}, psv[8] = {ps0.x, ps0.y, ps0.z, ps0.w, ps1.x, ps1.y, ps1.z, ps1.w};
#pragma unroll
            for (int r = 0; r < 4; ++r) {
                const float gf[8] = {bf_lo(gt[r].x), bf_hi(gt[r].x), bf_lo(gt[r].y), bf_hi(gt[r].y), bf_lo(gt[r].z), bf_hi(gt[r].z), bf_lo(gt[r].w), bf_hi(gt[r].w)};
                float y[8];
#pragma unroll
                for (int e = 0; e < 8; ++e) y[e] = (sm[r][e] + pbv[e]) * psv[e] * gf[e];
                u32x4 w; w.x = cvt_pk_bf16(y[0], y[1]); w.y = cvt_pk_bf16(y[2], y[3]); w.z = cvt_pk_bf16(y[4], y[5]); w.w = cvt_pk_bf16(y[6], y[7]);
                *(u32x4*)(Y + (size_t)(tf + r) * DM + pc0) = w; }
        }
        if (tile + G < NT) mixer_load_h(P, tile + G, wave, lane, hv);
#pragma unroll
        for (int rr = 0; rr < 4; ++rr) { const int row = 4 * wave + rr;
            f32x4 v0 = *(const LAS f32x4*)(Cs + row * 512 + 4 * lane), v1 = *(const LAS f32x4*)(Cs + row * 512 + 256 + 4 * lane);
            const float mean = wave_sum((v0.x + v0.y) + (v0.z + v0.w) + (v1.x + v1.y) + (v1.z + v1.w)) * (1.0f / 512.0f);
            v0 = v0 - mean; v1 = v1 - mean;
            const float var = wave_sum((v0.x * v0.x + v0.y * v0.y) + (v0.z * v0.z + v0.w * v0.w) + (v1.x * v1.x + v1.y * v1.y) + (v1.z * v1.z + v1.w * v1.w)) * (1.0f / 512.0f);
            const float rstd = 1.0f / sqrtf(var + 1e-5f);
            v0 = v0 * rstd * lg0 + lb0; v1 = v1 * rstd * lg1 + lb1;
            u32x2 w0, w1; w0.x = cvt_pk_bf16(silu(v0.x), silu(v0.y)); w0.y = cvt_pk_bf16(silu(v0.z), silu(v0.w)); w1.x = cvt_pk_bf16(silu(v1.x), silu(v1.y)); w1.y = cvt_pk_bf16(silu(v1.z), silu(v1.w));
            bf16* o = HC + (size_t)(t0 + row) * WC; *(u32x2*)(o + 4 * lane) = w0; *(u32x2*)(o + 256 + 4 * lane) = w1; }
    }
    __syncthreads();
}

__device__ __forceinline__ void phase_final(const Params& p, int bid, int G) {
    int tid_ = threadIdx.x; asm volatile("" : "+v"(tid_)); const int tid = tid_, lane = tid & 63, wave = __builtin_amdgcn_readfirstlane(tid >> 6);
    const bf16* DL = (const bf16*)(p.ws + WS_DELTA);
    const int gw = bid * 8 + wave, NGW = G * 8;
    f32x4 gv[4];
#pragma unroll
    for (int j = 0; j < 4; ++j) gv[j] = *((const f32x4*)p.final_g + lane + 64 * j);
    for (int m = gw; m < MTOK; m += NGW) {
        const f32x4* xr = (const f32x4*)(p.x + (size_t)m * DM) + lane; const u32x2* dr = (const u32x2*)(DL + (size_t)m * DM) + lane;
        f32x4 v[4]; u32x2 d[4];
#pragma unroll
        for (int j = 0; j < 4; ++j) { v[j] = xr[64 * j]; d[j] = dr[64 * j]; }
        float s = 0.f;
#pragma unroll
        for (int j = 0; j < 4; ++j) { v[j].x += bf_lo(d[j].x); v[j].y += bf_hi(d[j].x); v[j].z += bf_lo(d[j].y); v[j].w += bf_hi(d[j].y);
            s += (v[j].x * v[j].x + v[j].y * v[j].y) + (v[j].z * v[j].z + v[j].w * v[j].w); }
        const float r = 1.0f / sqrtf(wave_sum(s) * (1.0f / DM) + 1e-6f);
        f32x4* o = (f32x4*)(p.out + (size_t)m * DM) + lane;
#pragma unroll
        for (int j = 0; j < 4; ++j) o[64 * j] = v[j] * r * gv[j];
    }
}

__global__ void __launch_bounds__(NTHR, 2) fwd_mega(Params p) {
    extern __shared__ __attribute__((aligned(16))) unsigned char lds_raw[];
    LAS unsigned char* lds = (LAS unsigned char*)lds_raw;
    const int bid = blockIdx.x, G = gridDim.x;
    const bf16* WinT = (const bf16*)(p.ws + WS_WIN); const bf16* PwT = (const bf16*)(p.ws + WS_PW); const bf16* WoutT = (const bf16*)(p.ws + WS_WOUT);
    const bf16* HN = (const bf16*)(p.ws + WS_HN); bf16* P = (bf16*)(p.ws + WS_P); const bf16* HC = (const bf16*)(p.ws + WS_HC); bf16* Y = (bf16*)(p.ws + WS_Y);
    bf16* DL = (bf16*)(p.ws + WS_DELTA);

    volatile LAS unsigned* MISC = (volatile LAS unsigned*)(lds + MISC_OFF);
    if (threadIdx.x < 64) MISC[threadIdx.x] = 0u;
    __syncthreads();
    XcdBarrier bar = xcd_barrier_post((unsigned*)(p.ws + WS_BAR), MISC + 8);
#define GSYNC() xcd_barrier(bar)
    phase_prep(p, lds, bid, G);
    GSYNC();
    {
        pg8::Gemm g{HN, WinT, MTOK, DIN, DM}; pg8::StaticOrder S; S.init(MTOK, DIN, G, bid);
        pg8::EpiProj E{P};
        pg8::gemm_phase<pg8::EpiProj, pg8::StaticOrder, true, true>(lds, g, S, E);
    }
    GSYNC();
    phase_mixer(p, lds, bid, G);
    GSYNC();
    {
        pg8::Gemm g{HC, PwT, MTOK, WC, WC}; pg8::StaticOrder S; S.init(MTOK, WC, G, bid);
        pg8::EpiPw E{P, Y, p.pw_b};
        pg8::gemm_phase<pg8::EpiPw, pg8::StaticOrder, true, true>(lds, g, S, E);
    }
    GSYNC();
    {
        pg8::Gemm g{Y, WoutT, MTOK, DM, DM}; pg8::StaticOrder S; S.init(MTOK, DM, G, bid);
        pg8::EpiDelta E{DL};
        pg8::gemm_phase<pg8::EpiDelta, pg8::StaticOrder, true, true>(lds, g, S, E);
    }
    GSYNC();
    phase_final(p, bid, G);
}

extern "C" void kernel_launch(void* const* d_in, const int* in_sizes, int n_in, void* d_out, int out_size, void* d_ws, size_t ws_size, hipStream_t stream) {
    static int grid_blocks = 0;
    if (grid_blocks == 0) {
        if (n_in != 14 || in_sizes[0] != MTOK * DM || out_size != MTOK * DM || ws_size < WS_END) { fprintf(stderr, "kernel_launch: unexpected shapes (n_in %d, ws %zu)\n", n_in, ws_size); grid_blocks = -1; return; }
        int dev = 0, cus = 0, per_cu = 0;
        (void)hipGetDevice(&dev); (void)hipDeviceGetAttribute(&cus, hipDeviceAttributeMultiprocessorCount, dev);
        if (hipFuncSetAttribute((const void*)fwd_mega, hipFuncAttributeMaxDynamicSharedMemorySize, LDS_BYTES) != hipSuccess) { fprintf(stderr, "kernel_launch: hipFuncSetAttribute failed\n"); grid_blocks = -1; return; }
        if (hipOccupancyMaxActiveBlocksPerMultiprocessor(&per_cu, (const void*)fwd_mega, NTHR, LDS_BYTES) != hipSuccess || per_cu < 1) { fprintf(stderr, "kernel_launch: occupancy query failed (%d)\n", per_cu); (void)hipGetLastError(); per_cu = 1; }
        if (per_cu > 1) per_cu = 1;
        grid_blocks = cus * per_cu;
    }
    if (grid_blocks < 0) return;
    Params p{};
    p.x = (const float*)d_in[0]; p.norm_g = (const float*)d_in[1]; p.w_in = (const float*)d_in[2]; p.pool_w = (const float*)d_in[3]; p.pool_b = (const float*)d_in[4];
    p.pool_scale = (const float*)d_in[5]; p.conv_dw = (const float*)d_in[6]; p.conv_b = (const float*)d_in[7]; p.ln_g = (const float*)d_in[8]; p.ln_b = (const float*)d_in[9];
    p.pw_w = (const float*)d_in[10]; p.pw_b = (const float*)d_in[11]; p.w_out = (const float*)d_in[12]; p.final_g = (const float*)d_in[13];
    p.out = (float*)d_out; p.ws = (unsigned char*)d_ws;
    if (hipMemsetAsync((char*)d_ws + WS_BAR, 0, 16384, stream) != hipSuccess) { fprintf(stderr, "kernel_launch: memset failed\n"); return; }
    hipLaunchKernelGGL(fwd_mega, dim3(grid_blocks), dim3(NTHR), LDS_BYTES, stream, p);
    const hipError_t e = hipPeekAtLastError();
    if (e != hipSuccess) fprintf(stderr, "kernel_launch: launch failed: %s (grid %d)\n", hipGetErrorString(e), grid_blocks);
}
```

```cpp
#include <hip/hip_runtime.h>
#include <cstdio>
#include <cstdint>
namespace pg8 {
#define PG8_LAS __attribute__((address_space(3)))
typedef unsigned short bf16_t;
typedef short bf16x8 __attribute__((ext_vector_type(8)));
typedef float f32x4 __attribute__((ext_vector_type(4)));
typedef unsigned u32x4 __attribute__((ext_vector_type(4)));
constexpr int BM = 256, BK = 64, HALF = 128, HTB = HALF * BK * 2  , STAGE_BYTES = 8 * HTB, NXCD = 8, WGM = 8;

__host__ __device__ __forceinline__ int lds_byte(int r, int c) { const int st = (r >> 4) * 2 + (c >> 5), rr = r & 15, cc = c & 31, ob = rr * 64 + cc * 2; return st * 1024 + (ob ^ (((ob >> 9) & 1) << 5)); }
__host__ __device__ __forceinline__ void stage_rc(int b, int& R, int& C) { const int st = b / 1024, sb = b % 1024, swz = sb ^ (((sb >> 9) & 1) << 5); R = (st >> 1) * 16 + swz / 64; C = (st & 1) * 32 + (swz % 64) / 2; }
__host__ __device__ __forceinline__ int perm32(int rho) { const int n = rho >> 4, i = rho & 15; return 8 * (i >> 2) + 4 * n + (i & 3); }

struct Unit { int pm, pn; };
struct Gemm { const bf16_t* A; const bf16_t* Bt; int M, N, K; };

struct StaticOrder {
    int nM, nN, nwg, G, c;
    __host__ __device__ void init(int M, int N, int G_, int c_) { nM = M / BM; nN = N / BM; nwg = nM * nN; G = G_; c = c_; }
    __host__ __device__ bool next(int i, Unit& u) const {
        const long L = (long)i * G + c; if (L >= nwg) return false;
        int wgid = (int)L; { const int q = nwg / NXCD, r = nwg % NXCD, xcd = wgid % NXCD, off = wgid / NXCD; wgid = (xcd < r ? xcd * (q + 1) : r * (q + 1) + (xcd - r) * q) + off; }
        const int nig = WGM * nN, gid = wgid / nig, fm = gid * WGM, gsz = (nM - fm) < WGM ? (nM - fm) : WGM;
        u.pm = fm + ((wgid % nig) % gsz); u.pn = (wgid % nig) / gsz; return true;
    }
    __device__ __forceinline__ void a_ready(const Unit&) const {}
    __device__ __forceinline__ void done(const Unit&) const {}
};
__device__ __forceinline__ unsigned cvt_pk_bf16(float lo, float hi) { unsigned r; asm volatile("v_cvt_pk_bf16_f32 %0, %1, %2" : "=v"(r) : "v"(lo), "v"(hi)); return r; }
typedef float f32x2 __attribute__((ext_vector_type(2)));

__device__ __forceinline__ float sigm(float v) { return __builtin_amdgcn_rcpf(1.0f + __expf(-v)); }
__device__ __forceinline__ float silu(float v) { return v * sigm(v); }
constexpr size_t PSEC = (size_t)16 * 2048 * 512;
struct EpiProj {
    static constexpr bool PERM = true, AFTER_DRAIN = false;
    bf16_t* P;
    __device__ __forceinline__ void operator()(const f32x4 (&acc)[2][2][4][2], const Unit& u, int wr, int wc, int fr, int fq) const {
        const int row0 = u.pm * BM + wr * 64 + fr; const int pn = u.pn;
        if (pn >= 4 && pn < 8) {
            const int col0 = 128 * (pn - 4) + wc * 32 + 8 * fq; bf16_t* Ps = P + (size_t)2 * PSEC;
#pragma unroll
            for (int ai = 0; ai < 2; ++ai)
#pragma unroll
                for (int m = 0; m < 4; ++m) { bf16_t* rowp = Ps + (size_t)(row0 + ai * HALF + m * 16) * 512 + col0;
                    const f32x4 v0 = acc[ai][0][m][0], v1 = acc[ai][0][m][1], g0 = acc[ai][1][m][0], g1 = acc[ai][1][m][1];
                    u32x4 w; w.x = cvt_pk_bf16(v0[0] * sigm(g0[0]), v0[1] * sigm(g0[1])); w.y = cvt_pk_bf16(v0[2] * sigm(g0[2]), v0[3] * sigm(g0[3]));
                    w.z = cvt_pk_bf16(v1[0] * sigm(g1[0]), v1[1] * sigm(g1[1])); w.w = cvt_pk_bf16(v1[2] * sigm(g1[2]), v1[3] * sigm(g1[3]));
                    *(u32x4*)rowp = w; }
        } else {
            const int sec = pn < 2 ? 0 : (pn < 4 ? 1 : 3), colbase = 256 * (pn & 1); const bool act = pn >= 2;
            const int col0 = colbase + wc * 32 + 8 * fq; bf16_t* Ps = P + (size_t)sec * PSEC;
#pragma unroll
            for (int ai = 0; ai < 2; ++ai)
#pragma unroll
                for (int m = 0; m < 4; ++m) { bf16_t* rowp = Ps + (size_t)(row0 + ai * HALF + m * 16) * 512 + col0;
#pragma unroll
                    for (int bj = 0; bj < 2; ++bj) { f32x4 v0 = acc[ai][bj][m][0], v1 = acc[ai][bj][m][1];
                        if (act) {
#pragma unroll
                            for (int j = 0; j < 4; ++j) { v0[j] = silu(v0[j]); v1[j] = silu(v1[j]); } }
                        u32x4 w; w.x = cvt_pk_bf16(v0[0], v0[1]); w.y = cvt_pk_bf16(v0[2], v0[3]); w.z = cvt_pk_bf16(v1[0], v1[1]); w.w = cvt_pk_bf16(v1[2], v1[3]);
                        *(u32x4*)(rowp + bj * HALF) = w; } }
        }
    }
};
__device__ __forceinline__ float bf_lo(unsigned w) { return __uint_as_float(w << 16); }
__device__ __forceinline__ float bf_hi(unsigned w) { return __uint_as_float(w & 0xffff0000u); }
struct EpiPw {
    static constexpr bool PERM = true, AFTER_DRAIN = false;
    const bf16_t* P; bf16_t* Y; const float* bias;
    __device__ __forceinline__ void operator()(const f32x4 (&acc)[2][2][4][2], const Unit& u, int wr, int wc, int fr, int fq) const {
        const int row0 = u.pm * BM + wr * 64 + fr; const int col0 = u.pn * BM + wc * 32 + 8 * fq;
        f32x4 bv[2][2];
#pragma unroll
        for (int bj = 0; bj < 2; ++bj)
#pragma unroll
            for (int n = 0; n < 2; ++n) bv[bj][n] = *(const f32x4*)(bias + col0 + bj * HALF + 4 * n);
#pragma unroll
        for (int ai = 0; ai < 2; ++ai)
#pragma unroll
            for (int m = 0; m < 4; ++m) { const size_t row = (size_t)(row0 + ai * HALF + m * 16);
#pragma unroll
                for (int bj = 0; bj < 2; ++bj) { const u32x4 gt = *(const u32x4*)(P + 3 * PSEC + row * 512 + col0 + bj * HALF);
                    const f32x4 v0 = acc[ai][bj][m][0] + bv[bj][0], v1 = acc[ai][bj][m][1] + bv[bj][1];
                    u32x4 w; w.x = cvt_pk_bf16(v0[0] * bf_lo(gt.x), v0[1] * bf_hi(gt.x)); w.y = cvt_pk_bf16(v0[2] * bf_lo(gt.y), v0[3] * bf_hi(gt.y));
                    w.z = cvt_pk_bf16(v1[0] * bf_lo(gt.z), v1[1] * bf_hi(gt.z)); w.w = cvt_pk_bf16(v1[2] * bf_lo(gt.w), v1[3] * bf_hi(gt.w));
                    *(u32x4*)(Y + row * 1024 + 512 + col0 + bj * HALF) = w; } }
    }
};
struct EpiDelta {
    static constexpr bool PERM = true, AFTER_DRAIN = false;
    bf16_t* O;
    __device__ __forceinline__ void operator()(const f32x4 (&acc)[2][2][4][2], const Unit& u, int wr, int wc, int fr, int fq) const {
        const int row0 = u.pm * BM + wr * 64 + fr; const int col0 = u.pn * BM + wc * 32 + 8 * fq;
#pragma unroll
        for (int ai = 0; ai < 2; ++ai)
#pragma unroll
            for (int m = 0; m < 4; ++m) { bf16_t* rowp = O + (size_t)(row0 + ai * HALF + m * 16) * 1024 + col0;
#pragma unroll
                for (int bj = 0; bj < 2; ++bj) { const f32x4 v0 = acc[ai][bj][m][0], v1 = acc[ai][bj][m][1];
                    u32x4 w; w.x = cvt_pk_bf16(v0[0], v0[1]); w.y = cvt_pk_bf16(v0[2], v0[3]); w.z = cvt_pk_bf16(v1[0], v1[1]); w.w = cvt_pk_bf16(v1[2], v1[3]);
                    *(u32x4*)(rowp + bj * HALF) = w; } }
    }
};

template <class Epi, class Sched, bool ALIGN_EPI = false, bool SP2 = false>
__device__ __forceinline__ void gemm_phase(PG8_LAS unsigned char* lds, const Gemm g, const Sched& S, const Epi& E) {
    int tid_ = threadIdx.x; asm volatile("" : "+v"(tid_));
    const int tid = tid_, wid = __builtin_amdgcn_readfirstlane(tid >> 6), lane = tid & 63, wr = wid >> 2, wc = wid & 3, fr = lane & 15, fq = lane >> 4;
    const int K = g.K, nt = K / BK;
    unsigned voffA[2], voffB[2];
#pragma unroll
    for (int i = 0; i < 2; ++i) { int R, C; stage_rc(tid * 16 + i * 8192, R, C); const int Rb = Epi::PERM ? ((R & ~31) + perm32(R & 31)) : R;
        voffA[i] = (unsigned)(R * K + C) * 2u; voffB[i] = (unsigned)(Rb * K + C) * 2u; }
    const size_t kstep = (size_t)(BK * 2);
    const size_t hstep = (size_t)HALF * K * 2;
    const size_t tstep = 2 * hstep;
    const unsigned ldsw = (unsigned)wid * 1024u;
    const int aoff = lds_byte(wr * 64 + fr, fq * 8), boff = lds_byte(wc * 32 + fr, fq * 8);
#define PG8_SA(b, h) (((b) * 2 + (h)) * HTB)
#define PG8_SB(b, h) ((4 + (b) * 2 + (h)) * HTB)
#define PG8_STAGE(bufoff, gbase, voff) do { _Pragma("unroll") for (int _i = 0; _i < 2; ++_i) \
        __builtin_amdgcn_global_load_lds((const unsigned*)((const char*)(gbase) + (voff)[_i]), (PG8_LAS unsigned*)(lds + (bufoff) + ldsw + _i * 8192), 16, 0, 0); } while (0)
#define PG8_LDA(dst, b, h) do { _Pragma("unroll") for (int m = 0; m < 4; ++m) _Pragma("unroll") for (int k = 0; k < 2; ++k) dst[m][k] = *(const PG8_LAS bf16x8*)(lds + PG8_SA(b, h) + aoff + m * 2048 + k * 1024); } while (0)
#define PG8_LDB(dst, b, h) do { _Pragma("unroll") for (int n = 0; n < 2; ++n) _Pragma("unroll") for (int k = 0; k < 2; ++k) dst[n][k] = *(const PG8_LAS bf16x8*)(lds + PG8_SB(b, h) + boff + n * 2048 + k * 1024); } while (0)
#define PG8_MMA(ai, bj, At, Bt) do { __builtin_amdgcn_s_setprio(1); _Pragma("unroll") for (int m = 0; m < 4; ++m) _Pragma("unroll") for (int n = 0; n < 2; ++n) _Pragma("unroll") for (int k = 0; k < 2; ++k) \
        acc[ai][bj][m][n] = __builtin_amdgcn_mfma_f32_16x16x32_bf16(Bt[n][k], At[m][k], acc[ai][bj][m][n], 0, 0, 0); __builtin_amdgcn_s_setprio(0); } while (0)
#define PG8_WAIT_V(n) asm volatile("s_waitcnt vmcnt(" #n ")" ::: "memory")
#define PG8_WAIT_L(n) asm volatile("s_waitcnt lgkmcnt(" #n ")" ::: "memory")
#define PG8_BAR __builtin_amdgcn_s_barrier()
#define PG8_SCHED __builtin_amdgcn_sched_barrier(0)
    Unit cur, nxt; int ui = 0;
    if (!S.next(0, cur)) return;
    f32x4 acc[2][2][4][2];
#pragma unroll
    for (int a = 0; a < 2; ++a)
#pragma unroll
        for (int b = 0; b < 2; ++b)
#pragma unroll
            for (int m = 0; m < 4; ++m)
#pragma unroll
                for (int n = 0; n < 2; ++n) acc[a][b][m][n] = (f32x4){0.f, 0.f, 0.f, 0.f};
    bf16x8 At[4][2], B0[2][2], B1[2][2];
    const char* cA = (const char*)g.A + (size_t)cur.pm * tstep; const char* cB = (const char*)g.Bt + (size_t)cur.pn * tstep;
    S.a_ready(cur);
    if constexpr (SP2) {
        PG8_STAGE(PG8_SB(0, 0), cB, voffB); PG8_STAGE(PG8_SB(0, 1), cB + hstep, voffB); PG8_STAGE(PG8_SA(0, 0), cA, voffA); PG8_STAGE(PG8_SA(0, 1), cA + hstep, voffA);
        if (wr == 1) PG8_BAR;
        PG8_WAIT_V(2); PG8_BAR;
        PG8_STAGE(PG8_SB(1, 0), cB + kstep, voffB); PG8_STAGE(PG8_SA(1, 0), cA + kstep, voffA); PG8_STAGE(PG8_SB(1, 1), cB + hstep + kstep, voffB);
        PG8_WAIT_V(6); PG8_BAR;
    } else {
        PG8_STAGE(PG8_SB(0, 0), cB, voffB); PG8_STAGE(PG8_SA(0, 0), cA, voffA); PG8_STAGE(PG8_SB(0, 1), cB + hstep, voffB); PG8_STAGE(PG8_SA(0, 1), cA + hstep, voffA);
        if (wr == 1) PG8_BAR;
        PG8_WAIT_V(4); PG8_BAR;
        PG8_STAGE(PG8_SB(1, 0), cB + kstep, voffB); PG8_STAGE(PG8_SA(1, 0), cA + kstep, voffA); PG8_STAGE(PG8_SB(1, 1), cB + hstep + kstep, voffB);
        PG8_WAIT_V(6); PG8_BAR;
    }
    for (;;) {
        const bool has_next = S.next(ui + 1, nxt);
        const char* nA = has_next ? (const char*)g.A + (size_t)nxt.pm * tstep : cA; const char* nB = has_next ? (const char*)g.Bt + (size_t)nxt.pn * tstep : cB;
        for (int t = 0; t < nt; t += 2) {
            const bool last = (t == nt - 2);
            const char* a1 = cA + (size_t)(t + 1) * kstep;
            const char* a2 = last ? nA : cA + (size_t)(t + 2) * kstep; const char* b2 = last ? nB : cB + (size_t)(t + 2) * kstep;
            const char* a3 = a2 + kstep; const char* b3 = b2 + kstep;
            if (last && has_next) S.a_ready(nxt);
            if constexpr (SP2) {
            PG8_LDB(B0, 0, 0); PG8_LDB(B1, 0, 1); PG8_SCHED; PG8_LDA(At, 0, 0); PG8_STAGE(PG8_SA(1, 1), a1 + hstep, voffA);
            PG8_WAIT_V(8); PG8_WAIT_L(0); PG8_BAR; PG8_MMA(0, 0, At, B0); PG8_MMA(0, 1, At, B1); PG8_BAR; PG8_SCHED;
            PG8_LDA(At, 0, 1); PG8_STAGE(PG8_SB(0, 0), b2, voffB); PG8_STAGE(PG8_SB(0, 1), b2 + hstep, voffB); PG8_STAGE(PG8_SA(0, 0), a2, voffA);
            PG8_WAIT_V(8); PG8_WAIT_L(0); PG8_BAR; PG8_MMA(1, 0, At, B0); PG8_MMA(1, 1, At, B1); PG8_BAR; PG8_SCHED;
            PG8_LDB(B0, 1, 0); PG8_LDB(B1, 1, 1); PG8_SCHED; PG8_LDA(At, 1, 0); PG8_STAGE(PG8_SA(0, 1), a2 + hstep, voffA);
            PG8_WAIT_V(8); PG8_WAIT_L(0); PG8_BAR; PG8_MMA(0, 0, At, B0); PG8_MMA(0, 1, At, B1); PG8_BAR; PG8_SCHED;
            PG8_LDA(At, 1, 1); PG8_STAGE(PG8_SB(1, 0), b3, voffB); PG8_STAGE(PG8_SB(1, 1), b3 + hstep, voffB); PG8_STAGE(PG8_SA(1, 0), a3, voffA);
            PG8_WAIT_V(8); PG8_WAIT_L(0); PG8_BAR; PG8_MMA(1, 0, At, B0); PG8_MMA(1, 1, At, B1); PG8_BAR; PG8_SCHED;
            } else {
            PG8_LDB(B0, 0, 0); PG8_SCHED; PG8_LDA(At, 0, 0); PG8_STAGE(PG8_SA(1, 1), a1 + hstep, voffA);
            PG8_WAIT_L(8); PG8_BAR; PG8_WAIT_L(0); PG8_MMA(0, 0, At, B0); PG8_BAR; PG8_SCHED;
            PG8_LDB(B1, 0, 1); PG8_STAGE(PG8_SB(0, 0), b2, voffB);
            PG8_BAR; PG8_WAIT_L(0); PG8_MMA(0, 1, At, B1); PG8_BAR;
            PG8_LDA(At, 0, 1); PG8_STAGE(PG8_SA(0, 0), a2, voffA);
            PG8_BAR; PG8_WAIT_L(0); PG8_MMA(1, 0, At, B0); PG8_BAR; PG8_SCHED;
            PG8_STAGE(PG8_SB(0, 1), b2 + hstep, voffB);
            PG8_WAIT_V(6); PG8_BAR; PG8_MMA(1, 1, At, B1); PG8_BAR;
            PG8_LDB(B0, 1, 0); PG8_SCHED; PG8_LDA(At, 1, 0); PG8_STAGE(PG8_SA(0, 1), a2 + hstep, voffA);
            PG8_WAIT_L(8); PG8_BAR; PG8_WAIT_L(0); PG8_MMA(0, 0, At, B0); PG8_BAR; PG8_SCHED;
            PG8_LDB(B1, 1, 1); PG8_STAGE(PG8_SB(1, 0), b3, voffB);
            PG8_BAR; PG8_WAIT_L(0); PG8_MMA(0, 1, At, B1); PG8_BAR;
            PG8_LDA(At, 1, 1); PG8_STAGE(PG8_SA(1, 0), a3, voffA);
            PG8_BAR; PG8_WAIT_L(0); PG8_MMA(1, 0, At, B0); PG8_BAR; PG8_SCHED;
            PG8_STAGE(PG8_SB(1, 1), b3 + hstep, voffB);
            PG8_WAIT_V(6); PG8_BAR; PG8_MMA(1, 1, At, B1); PG8_BAR;
            }
        }
        if constexpr (ALIGN_EPI) { if (wr == 0) PG8_BAR; }
        if constexpr (!Epi::AFTER_DRAIN) { E(acc, cur, wr, wc, fr, fq); S.done(cur); }
        if (!has_next) break;
#pragma unroll
        for (int a = 0; a < 2; ++a)
#pragma unroll
            for (int b = 0; b < 2; ++b)
#pragma unroll
                for (int m = 0; m < 4; ++m)
#pragma unroll
                    for (int n = 0; n < 2; ++n) acc[a][b][m][n] = (f32x4){0.f, 0.f, 0.f, 0.f};
        cur = nxt; cA = nA; cB = nB; ++ui;
        if constexpr (ALIGN_EPI) { if (wr == 1) PG8_BAR; }
    }
    PG8_WAIT_V(0);
    if constexpr (!ALIGN_EPI) { if (wr == 0) PG8_BAR; }
    PG8_BAR;
    if constexpr (Epi::AFTER_DRAIN) { E.fused(acc, cur, wr, wc, fr, fq, lds, wid, lane); S.done(cur); }
#undef PG8_SA
#undef PG8_SB
#undef PG8_STAGE
#undef PG8_LDA
#undef PG8_LDB
#undef PG8_MMA
#undef PG8_WAIT_V
#undef PG8_WAIT_L
#undef PG8_BAR
#undef PG8_SCHED
}
}

constexpr int MTOK = 16 * 2048, SEQ = 2048, DM = 1024, DIN = 2560, WP = 512, WC = 512;
constexpr int MISC_OFF = 131072, LDS_BYTES = 131072 + 256, NTHR = 512;
constexpr size_t WS_WIN = 0, WS_PW = WS_WIN + (size_t)DIN * DM * 2, WS_WOUT = WS_PW + (size_t)WC * WC * 2, WS_HN = WS_WOUT + (size_t)DM * DM * 2,
                 WS_P = WS_HN + (size_t)MTOK * DM * 2, WS_HC = WS_P + (size_t)MTOK * 2048 * 2, WS_Y = WS_HC + (size_t)MTOK * WC * 2, WS_PART = WS_Y + (size_t)MTOK * DM * 2,
                 WS_BAR = WS_PART + (size_t)MTOK * 16 * 4, WS_DELTA = WS_HN  , WS_END = WS_BAR + 16384;
#define LAS __attribute__((address_space(3)))
typedef unsigned short bf16;
typedef float f32x4 __attribute__((ext_vector_type(4)));
typedef float f32x2 __attribute__((ext_vector_type(2)));
typedef unsigned u32x4 __attribute__((ext_vector_type(4)));
typedef unsigned u32x2 __attribute__((ext_vector_type(2)));
#define LDS_WAIT() asm volatile("s_waitcnt lgkmcnt(0)" ::: "memory")
using pg8::cvt_pk_bf16; using pg8::silu; using pg8::bf_lo; using pg8::bf_hi;

#define RLX_AGENT __ATOMIC_RELAXED, __HIP_MEMORY_SCOPE_AGENT
#define XB_TMO      128
#define XB_XCNT(j)  (256  + 64 * (j))
#define XB_XSUB(j)  (1280 + 64 * (j))
#define XB_XGEN(j)  (2304 + 64 * (j))
#define XB_TOP      3328
#define XB_TOPGEN   3392
#define XCD_BAR_WORDS 3456
#define XB_SPIN_CAP (1u << 18)

__device__ __forceinline__ unsigned xb_ld(unsigned* p)              { return __hip_atomic_load(p, __ATOMIC_RELAXED, __HIP_MEMORY_SCOPE_AGENT); }
__device__ __forceinline__ unsigned xb_add(unsigned* p, unsigned v) { return __hip_atomic_fetch_add(p, v, __ATOMIC_RELAXED, __HIP_MEMORY_SCOPE_AGENT); }
__device__ __forceinline__ unsigned xb_xcc_id() { return (unsigned)__builtin_amdgcn_s_getreg((3 << 11) | 20) & 0xFu; }
#define XB_SPIN(cond, bar) do { unsigned _sp = 0; while (cond) { __builtin_amdgcn_s_sleep(1); \
    if ((++_sp & 255u) == 0u) { if (xb_ld(&(bar)[XB_TMO])) break; if (_sp > XB_SPIN_CAP) { atomicAdd(&(bar)[XB_TMO], 1u); break; } } } } while (0)

struct XcdBarrier {
    unsigned* bar; unsigned x;
    volatile LAS unsigned* st;
};

__device__ __forceinline__ XcdBarrier xcd_barrier_post(unsigned* bar, volatile LAS unsigned* st) {
    XcdBarrier b; b.bar = bar; b.x = xb_xcc_id(); b.st = st;
    if (threadIdx.x == 0) (void)xb_add(&bar[XB_XCNT(b.x)], 1u);
    return b;
}
__device__ __forceinline__ void xcd_barrier_complete(unsigned* bar, unsigned x, unsigned& nloc, unsigned& nx) {
    const unsigned G = gridDim.x * gridDim.y * gridDim.z;
    unsigned sum, cnt, mine, sp = 0u;
    for (;;) {
        sum = 0u; cnt = 0u; mine = 0u;
#pragma unroll
        for (unsigned j = 0; j < 16; ++j) { const unsigned c = xb_ld(&bar[XB_XCNT(j)]); sum += c; cnt += (c > 0u) ? 1u : 0u; mine = (j == x) ? c : mine; }
        if (sum == G) break;
        __builtin_amdgcn_s_sleep(1);
        if ((++sp & 255u) == 0u) { if (xb_ld(&bar[XB_TMO])) break; if (sp > XB_SPIN_CAP) { atomicAdd(&bar[XB_TMO], 1u); break; } }
    }
    nloc = mine > 0u ? mine : 1u; nx = cnt > 0u ? cnt : 1u;
}

__device__ __forceinline__ void xcd_barrier(const XcdBarrier& b) {
    asm volatile("s_waitcnt vmcnt(0)" ::: "memory");
    __syncthreads();
    if (threadIdx.x == 0) {
        unsigned* bar = b.bar;
        __builtin_amdgcn_s_waitcnt(0);
        unsigned nloc = b.st[0], nx = b.st[1];
        if (nloc == 0u) { xcd_barrier_complete(bar, b.x, nloc, nx); b.st[0] = nloc; b.st[1] = nx; }
        const unsigned old = xb_add(&bar[XB_XSUB(b.x)], 1u);
        const unsigned gen = old / nloc;
        if (old + 1u == (gen + 1u) * nloc) {
            __builtin_amdgcn_fence(__ATOMIC_RELEASE, "agent");
            asm volatile("s_waitcnt vmcnt(0)" ::: "memory");
            const unsigned og = xb_add(&bar[XB_TOP], 1u);
            const unsigned tg = og / nx;
            if (og + 1u == (tg + 1u) * nx) xb_add(&bar[XB_TOPGEN], 1u);
            else XB_SPIN(xb_ld(&bar[XB_TOPGEN]) == tg, bar);
            __builtin_amdgcn_fence(__ATOMIC_ACQUIRE, "agent");
            xb_add(&bar[XB_XGEN(b.x)], 1u);
            asm volatile("s_waitcnt vmcnt(0)" ::: "memory");
        } else {
            XB_SPIN(xb_ld(&bar[XB_XGEN(b.x)]) == gen, bar);
            __builtin_amdgcn_fence(__ATOMIC_ACQUIRE, "agent");
            asm volatile("s_waitcnt vmcnt(0)" ::: "memory");
        }
    }
    __syncthreads();
}

struct Params {
    const float *x, *norm_g, *w_in, *pool_w, *pool_b, *pool_scale, *conv_dw, *conv_b, *ln_g, *ln_b, *pw_w, *pw_b, *w_out, *final_g;
    float* out; unsigned char* ws;
};

__device__ __forceinline__ float wave_sum(float v) {
#pragma unroll
    for (int o = 1; o < 64; o <<= 1) v += __shfl_xor(v, o);
    return v;
}
__device__ __forceinline__ float wave_sum_dpp(float v) {
#define DPP_ADD(ctrl) v += __builtin_bit_cast(float, __builtin_amdgcn_update_dpp(0, __builtin_bit_cast(int, v), (ctrl), 0xf, 0xf, true))
    DPP_ADD(0xB1);
    DPP_ADD(0x4E);
    DPP_ADD(0x141);
    DPP_ADD(0x140);
#undef DPP_ADD
    const int b = __builtin_bit_cast(int, v);
    return (__builtin_bit_cast(float, __builtin_amdgcn_readlane(b, 0)) + __builtin_bit_cast(float, __builtin_amdgcn_readlane(b, 16))) + (__builtin_bit_cast(float, __builtin_amdgcn_readlane(b, 32)) + __builtin_bit_cast(float, __builtin_amdgcn_readlane(b, 48)));
}
__device__ __forceinline__ void transpose_item(const float* W, int ldw, int scol0, int k0, bf16* WT, int ldt, int drow0, LAS float* scr, int lane) {
    float tv[32];
#pragma unroll
    for (int i = 0; i < 32; ++i) tv[i] = W[(size_t)(k0 + 2 * i + (lane >> 5)) * ldw + scol0 + (lane & 31)];
#pragma unroll
    for (int i = 0; i < 32; ++i) scr[(2 * i + (lane >> 5)) * 33 + (lane & 31)] = tv[i];
    LDS_WAIT();
    const int c = lane & 7;
#pragma unroll
    for (int j = 0; j < 4; ++j) { const int n = (lane >> 3) + 8 * j; const LAS float* s = scr + (8 * c) * 33 + n;
        u32x4 o; o.x = cvt_pk_bf16(s[0 * 33], s[1 * 33]); o.y = cvt_pk_bf16(s[2 * 33], s[3 * 33]); o.z = cvt_pk_bf16(s[4 * 33], s[5 * 33]); o.w = cvt_pk_bf16(s[6 * 33], s[7 * 33]);
        *(u32x4*)(WT + (size_t)(drow0 + n) * ldt + k0 + 8 * c) = o; }
    LDS_WAIT();
}
__device__ __forceinline__ void poolfold_wg(const float* w_in, const float* pool_w, bf16* WinT, int g, int k0, LAS unsigned char* lds, int tid, int wave, int lane) {
    LAS float* pw = (LAS float*)lds;
    LAS float* wi = (LAS float*)(lds + 65536);
    const f32x4* src = (const f32x4*)(pool_w + (size_t)g * 128 * 128) + tid; f32x4 t[8];
#pragma unroll
    for (int i = 0; i < 8; ++i) t[i] = src[i * NTHR];
    const f32x4 wv = *(const f32x4*)(w_in + (size_t)(k0 + (tid >> 5)) * DIN + 128 * g + 4 * (tid & 31));
#pragma unroll
    for (int i = 0; i < 8; ++i) *((LAS f32x4*)pw + tid + i * NTHR) = t[i];
    *((LAS f32x4*)wi + tid) = wv;
    __syncthreads();
    float a00 = 0.f, a01 = 0.f, a10 = 0.f, a11 = 0.f;
    const LAS float* w0 = wi + (2 * wave) * 128; const LAS float* w1 = w0 + 128;
#pragma unroll 4
    for (int c4 = 0; c4 < 32; ++c4) { const f32x4 x0 = *(const LAS f32x4*)(w0 + 4 * c4), x1 = *(const LAS f32x4*)(w1 + 4 * c4);
#pragma unroll
        for (int cc = 0; cc < 4; ++cc) { const float p0 = pw[(4 * c4 + cc) * 128 + lane], p1 = pw[(4 * c4 + cc) * 128 + 64 + lane];
            a00 += x0[cc] * p0; a01 += x0[cc] * p1; a10 += x1[cc] * p0; a11 += x1[cc] * p1; } }
    *(unsigned*)(WinT + (size_t)(128 * g + lane) * DM + k0 + 2 * wave) = cvt_pk_bf16(a00, a10);
    *(unsigned*)(WinT + (size_t)(128 * g + 64 + lane) * DM + k0 + 2 * wave) = cvt_pk_bf16(a01, a11);
    __syncthreads();
}

__device__ __forceinline__ void phase_prep(const Params& p, LAS unsigned char* lds, int bid, int G) {
    int tid_ = threadIdx.x; asm volatile("" : "+v"(tid_)); const int tid = tid_, lane = tid & 63, wave = __builtin_amdgcn_readfirstlane(tid >> 6);
    LAS float* scr = (LAS float*)(lds + wave * 8704);
    bf16* WinT = (bf16*)(p.ws + WS_WIN); bf16* PwT = (bf16*)(p.ws + WS_PW); bf16* WoutT = (bf16*)(p.ws + WS_WOUT); bf16* HN = (bf16*)(p.ws + WS_HN);
    const int gw = bid * 8 + wave, NGW = G * 8;
    for (int t = bid; t < 256; t += G) poolfold_wg(p.w_in, p.pool_w, WinT, t & 3, 16 * (t >> 2), lds, tid, wave, lane);
    for (int t = gw; t < 1664; t += NGW) {
        if (t < 1024) { const int kb = t >> 6, nb = t & 63, n = 512 + 32 * nb; int scol;
            if (n < 1024 || n >= 2048) scol = n; else { const int q = (n - 1024) >> 8, r = (n - 1024) & 255; scol = r < 128 ? 1024 + 128 * q + r : 1536 + 128 * q + (r - 128); }
            transpose_item(p.w_in, DIN, scol, 64 * kb, WinT, DM, n, scr, lane); }
        else if (t < 1152) { const int it = t - 1024, kb = it >> 4, nb = it & 15; transpose_item(p.pw_w, WC, 32 * nb, 64 * kb, PwT, WC, 32 * nb, scr, lane); }
        else { const int it = t - 1152, kb = it >> 5, nb = it & 31; transpose_item(p.w_out, DM, 32 * nb, 64 * kb, WoutT, DM, 32 * nb, scr, lane); }
    }
    f32x4 gv[4];
#pragma unroll
    for (int j = 0; j < 4; ++j) gv[j] = *((const f32x4*)p.norm_g + lane + 64 * j);
    for (int m0 = gw * 4; m0 < MTOK; m0 += NGW * 4) {
        const f32x4* xr = (const f32x4*)(p.x + (size_t)m0 * DM) + lane; f32x4 v[4][4];
#pragma unroll
        for (int r = 0; r < 4; ++r)
#pragma unroll
            for (int j = 0; j < 4; ++j) v[r][j] = xr[r * 256 + 64 * j];
        __builtin_amdgcn_sched_barrier(0);
#pragma unroll
        for (int r = 0; r < 4; ++r) { float s = 0.f;
#pragma unroll
            for (int j = 0; j < 4; ++j) s += (v[r][j].x * v[r][j].x + v[r][j].y * v[r][j].y) + (v[r][j].z * v[r][j].z + v[r][j].w * v[r][j].w);
            const float rs = 1.0f / sqrtf(wave_sum_dpp(s) * (1.0f / DM) + 1e-6f);
            u32x2* o8 = (u32x2*)(HN + (size_t)(m0 + r) * DM) + lane;
#pragma unroll
            for (int j = 0; j < 4; ++j) { const f32x4 y = v[r][j] * rs * gv[j]; u32x2 w; w.x = cvt_pk_bf16(y.x, y.y); w.y = cvt_pk_bf16(y.z, y.w); o8[64 * j] = w; } }
    }
}

__device__ __forceinline__ void mixer_load_h(const bf16* P, int tile, int wave, int lane, u32x4 (&hv)[8]) {
    const int t0 = tile * 32, s0 = t0 & (SEQ - 1);
#pragma unroll
    for (int k = 0; k < 8; ++k) { const int r = wave + 8 * k; const bool ok = (s0 - 30 + r >= 0) && (r < 62);
        const u32x4 v = *(const u32x4*)(P + 2 * pg8::PSEC + (size_t)(ok ? t0 - 30 + r : t0) * 512 + lane * 8);
        hv[k] = ok ? v : (u32x4){0u, 0u, 0u, 0u}; }
}
#define GAS __attribute__((address_space(1)))
#define FMAC(acc, x_, y_) asm("v_fmac_f32 %0, %1, %2" : "+v"(acc) : "v"(x_), "v"(y_))
template <int W> __device__ __forceinline__ void pool_compute(const unsigned (&ur)[31], const unsigned (&ag)[16], int sa, f32x2 pb, f32x2 ps, bf16* yp) {
    float s0 = 0.f, s1 = 0.f;
#pragma unroll
    for (int i = 16 - W; i <= 15; ++i) { s0 += bf_lo(ur[i]); s1 += bf_hi(ur[i]); }
#pragma unroll
    for (int r = 0; r < 16; ++r) {
        if (r > 0) { s0 += bf_lo(ur[15 + r]) - bf_lo(ur[15 + r - W]); s1 += bf_hi(ur[15 + r]) - bf_hi(ur[15 + r - W]); }
        const int cnt = sa + r + 1 < W ? sa + r + 1 : W; const float inv = 1.0f / (float)cnt;
        const float z0 = s0 * inv - bf_lo(ur[15 + r]) + pb.x, z1 = s1 * inv - bf_hi(ur[15 + r]) + pb.y;
        *(unsigned*)(yp + (size_t)r * DM) = cvt_pk_bf16(z0 * ps.x * bf_lo(ag[r]), z1 * ps.y * bf_hi(ag[r]));
    }
}
__device__ __forceinline__ void phase_mixer(const Params& p, LAS unsigned char* lds, int bid, int G) {
    int tid_ = threadIdx.x; asm volatile("" : "+v"(tid_)); const int tid = tid_, lane = tid & 63, wave = __builtin_amdgcn_readfirstlane(tid >> 6);
    const bf16* P = (const bf16*)(p.ws + WS_P); bf16* HC = (bf16*)(p.ws + WS_HC); bf16* Y = (bf16*)(p.ws + WS_Y);
    LAS unsigned char* Hs = lds;
    LAS float* Cs = (LAS float*)(lds + 62 * 1024);
    const int cp = tid & 255, th = tid >> 8;
    const int pgp = wave & 3, pth = wave >> 2, pw_ = 2 << pgp, pc0 = 128 * pgp + 2 * lane;
    const f32x2 pb = *(const f32x2*)(p.pool_b + pc0), ps = *(const f32x2*)(p.pool_scale + pc0);
    const f32x4 lg0 = *(const f32x4*)(p.ln_g + 4 * lane), lg1 = *(const f32x4*)(p.ln_g + 256 + 4 * lane), lb0 = *(const f32x4*)(p.ln_b + 4 * lane), lb1 = *(const f32x4*)(p.ln_b + 256 + 4 * lane);
    const f32x2 cb = *(const f32x2*)(p.conv_b + 2 * cp);
    const int NT = MTOK / 32;
    f32x2 tw[31];
#pragma unroll
    for (int j = 0; j < 31; ++j) tw[j] = *(const f32x2*)(p.conv_dw + j * WC + 2 * cp);
    u32x4 hv[8];
    if (bid < NT) mixer_load_h(P, bid, wave, lane, hv);
    for (int tile = bid; tile < NT; tile += G) {
        const int t0 = tile * 32, s0 = t0 & (SEQ - 1);
        const int ta = t0 + 16 * pth, sa = s0 + 16 * pth;
#pragma unroll
        for (int k = 0; k < 8; ++k) { const int r = wave + 8 * k; if (r < 62) *(LAS u32x4*)(Hs + r * 1024 + lane * 16) = hv[k]; }
        unsigned ur[31], ag[16];
#pragma unroll
        for (int i = 0; i < 31; ++i) { const bool ok = (i >= 16 - pw_) && (sa - 15 + i >= 0);
            const unsigned v = *(const unsigned*)(P + (size_t)(ok ? ta - 15 + i : ta) * 512 + pc0); ur[i] = ok ? v : 0u; }
#pragma unroll
        for (int r = 0; r < 16; ++r) ag[r] = *(const unsigned*)(P + pg8::PSEC + (size_t)(ta + r) * 512 + pc0);
        if (tile + G < NT) mixer_load_h(P, tile + G, wave, lane, hv);
        __builtin_amdgcn_sched_barrier(0);
        __syncthreads();
        {
            float a0[16], a1[16];
#pragma unroll
            for (int r = 0; r < 16; ++r) { a0[r] = cb.x; a1[r] = cb.y; }
            const LAS unsigned* hp = (const LAS unsigned*)(Hs + (th * 16) * 1024 + cp * 4);
#pragma unroll
            for (int i = 0; i < 46; ++i) { const unsigned w = hp[i * 256]; const float v0 = bf_lo(w), v1 = bf_hi(w);
#pragma unroll
                for (int r = 0; r < 16; ++r) { const int j = i - r; if (j >= 0 && j <= 30) { FMAC(a0[r], tw[j].x, v0); FMAC(a1[r], tw[j].y, v1); } } }
#pragma unroll
            for (int r = 0; r < 16; ++r) *(LAS f32x2*)(Cs + (th * 16 + r) * 512 + 2 * cp) = (f32x2){a0[r], a1[r]};
        }
        __builtin_amdgcn_sched_barrier(0);
        __syncthreads();
#pragma unroll
        for (int rr = 0; rr < 4; ++rr) { const int row = 4 * wave + rr;
            f32x4 v0 = *(const LAS f32x4*)(Cs + row * 512 + 4 * lane), v1 = *(const LAS f32x4*)(Cs + row * 512 + 256 + 4 * lane);
            const float mean = wave_sum_dpp((v0.x + v0.y) + (v0.z + v0.w) + (v1.x + v1.y) + (v1.z + v1.w)) * (1.0f / 512.0f);
            v0 = v0 - mean; v1 = v1 - mean;
            const float var = wave_sum_dpp((v0.x * v0.x + v0.y * v0.y) + (v0.z * v0.z + v0.w * v0.w) + (v1.x * v1.x + v1.y * v1.y) + (v1.z * v1.z + v1.w * v1.w)) * (1.0f / 512.0f);
            const float rstd = 1.0f / sqrtf(var + 1e-5f);
            v0 = v0 * rstd * lg0 + lb0; v1 = v1 * rstd * lg1 + lb1;
            u32x2 w0, w1; w0.x = cvt_pk_bf16(silu(v0.x), silu(v0.y)); w0.y = cvt_pk_bf16(silu(v0.z), silu(v0.w)); w1.x = cvt_pk_bf16(silu(v1.x), silu(v1.y)); w1.y = cvt_pk_bf16(silu(v1.z), silu(v1.w));
            bf16* o = HC + (size_t)(t0 + row) * WC; *(u32x2*)(o + 4 * lane) = w0; *(u32x2*)(o + 256 + 4 * lane) = w1; }
        __builtin_amdgcn_sched_barrier(0);
        { bf16* yp = Y + (size_t)ta * DM + pc0;
          if (pgp == 0) pool_compute<2>(ur, ag, sa, pb, ps, yp); else if (pgp == 1) pool_compute<4>(ur, ag, sa, pb, ps, yp);
          else if (pgp == 2) pool_compute<8>(ur, ag, sa, pb, ps, yp); else pool_compute<16>(ur, ag, sa, pb, ps, yp); }
    }
    __syncthreads();
}

__device__ __forceinline__ void phase_final(const Params& p, int bid, int G) {
    int tid_ = threadIdx.x; asm volatile("" : "+v"(tid_)); const int tid = tid_, lane = tid & 63, wave = __builtin_amdgcn_readfirstlane(tid >> 6);
    const bf16* DL = (const bf16*)(p.ws + WS_DELTA);
    const int gw = bid * 8 + wave, NGW = G * 8;
    f32x4 gv[4];
#pragma unroll
    for (int j = 0; j < 4; ++j) gv[j] = *((const f32x4*)p.final_g + lane + 64 * j);
    for (int m0 = gw * 4; m0 < MTOK; m0 += NGW * 4) {
        const f32x4* xr = (const f32x4*)(p.x + (size_t)m0 * DM) + lane; const u32x2* dr = (const u32x2*)(DL + (size_t)m0 * DM) + lane;
        f32x4 v[4][4]; u32x2 d[4][4];
#pragma unroll
        for (int r = 0; r < 4; ++r)
#pragma unroll
            for (int j = 0; j < 4; ++j) { v[r][j] = xr[r * 256 + 64 * j]; d[r][j] = dr[r * 256 + 64 * j]; }
        __builtin_amdgcn_sched_barrier(0);
#pragma unroll
        for (int r = 0; r < 4; ++r) { float s = 0.f;
#pragma unroll
            for (int j = 0; j < 4; ++j) { v[r][j].x += bf_lo(d[r][j].x); v[r][j].y += bf_hi(d[r][j].x); v[r][j].z += bf_lo(d[r][j].y); v[r][j].w += bf_hi(d[r][j].y);
                s += (v[r][j].x * v[r][j].x + v[r][j].y * v[r][j].y) + (v[r][j].z * v[r][j].z + v[r][j].w * v[r][j].w); }
            const float rs = 1.0f / sqrtf(wave_sum_dpp(s) * (1.0f / DM) + 1e-6f);
            f32x4* o = (f32x4*)(p.out + (size_t)(m0 + r) * DM) + lane;
#pragma unroll
            for (int j = 0; j < 4; ++j) o[64 * j] = v[r][j] * rs * gv[j]; }
    }
}

__global__ void __launch_bounds__(NTHR, 2) fwd_mega(Params p) {
    extern __shared__ __attribute__((aligned(16))) unsigned char lds_raw[];
    LAS unsigned char* lds = (LAS unsigned char*)lds_raw;
    const int bid = blockIdx.x, G = gridDim.x;
    const bf16* WinT = (const bf16*)(p.ws + WS_WIN); const bf16* PwT = (const bf16*)(p.ws + WS_PW); const bf16* WoutT = (const bf16*)(p.ws + WS_WOUT);
    const bf16* HN = (const bf16*)(p.ws + WS_HN); bf16* P = (bf16*)(p.ws + WS_P); const bf16* HC = (const bf16*)(p.ws + WS_HC); bf16* Y = (bf16*)(p.ws + WS_Y);
    bf16* DL = (bf16*)(p.ws + WS_DELTA);

    volatile LAS unsigned* MISC = (volatile LAS unsigned*)(lds + MISC_OFF);
    if (threadIdx.x < 64) MISC[threadIdx.x] = 0u;
    __syncthreads();
    XcdBarrier bar = xcd_barrier_post((unsigned*)(p.ws + WS_BAR), MISC + 8);
#define GSYNC() xcd_barrier(bar)
    phase_prep(p, lds, bid, G);
    GSYNC();
    {
        pg8::Gemm g{HN, WinT, MTOK, DIN, DM}; pg8::StaticOrder S; S.init(MTOK, DIN, G, bid);
        pg8::EpiProj E{P};
        pg8::gemm_phase<pg8::EpiProj, pg8::StaticOrder, true, true>(lds, g, S, E);
    }
    GSYNC();
    phase_mixer(p, lds, bid, G);
    GSYNC();
    {
        pg8::Gemm g{HC, PwT, MTOK, WC, WC}; pg8::StaticOrder S; S.init(MTOK, WC, G, bid);
        pg8::EpiPw E{P, Y, p.pw_b};
        pg8::gemm_phase<pg8::EpiPw, pg8::StaticOrder, true, true>(lds, g, S, E);
    }
    GSYNC();
    {
        pg8::Gemm g{Y, WoutT, MTOK, DM, DM}; pg8::StaticOrder S; S.init(MTOK, DM, G, bid);
        pg8::EpiDelta E{DL};
        pg8::gemm_phase<pg8::EpiDelta, pg8::StaticOrder, true, true>(lds, g, S, E);
    }
    GSYNC();
    phase_final(p, bid, G);
}

extern "C" void kernel_launch(void* const* d_in, const int* in_sizes, int n_in, void* d_out, int out_size, void* d_ws, size_t ws_size, hipStream_t stream) {
    static int grid_blocks = 0;
    if (grid_blocks == 0) {
        if (n_in != 14 || in_sizes[0] != MTOK * DM || out_size != MTOK * DM || ws_size < WS_END) { fprintf(stderr, "kernel_launch: unexpected shapes (n_in %d, ws %zu)\n", n_in, ws_size); grid_blocks = -1; return; }
        int dev = 0, cus = 0, per_cu = 0;
        (void)hipGetDevice(&dev); (void)hipDeviceGetAttribute(&cus, hipDeviceAttributeMultiprocessorCount, dev);
        if (hipFuncSetAttribute((const void*)fwd_mega, hipFuncAttributeMaxDynamicSharedMemorySize, LDS_BYTES) != hipSuccess) { fprintf(stderr, "kernel_launch: hipFuncSetAttribute failed\n"); grid_blocks = -1; return; }
        if (hipOccupancyMaxActiveBlocksPerMultiprocessor(&per_cu, (const void*)fwd_mega, NTHR, LDS_BYTES) != hipSuccess || per_cu < 1) { fprintf(stderr, "kernel_launch: occupancy query failed (%d)\n", per_cu); (void)hipGetLastError(); per_cu = 1; }
        if (per_cu > 1) per_cu = 1;
        grid_blocks = cus * per_cu;
    }
    if (grid_blocks < 0) return;
    Params p{};
    p.x = (const float*)d_in[0]; p.norm_g = (const float*)d_in[1]; p.w_in = (const float*)d_in[2]; p.pool_w = (const float*)d_in[3]; p.pool_b = (const float*)d_in[4];
    p.pool_scale = (const float*)d_in[5]; p.conv_dw = (const float*)d_in[6]; p.conv_b = (const float*)d_in[7]; p.ln_g = (const float*)d_in[8]; p.ln_b = (const float*)d_in[9];
    p.pw_w = (const float*)d_in[10]; p.pw_b = (const float*)d_in[11]; p.w_out = (const float*)d_in[12]; p.final_g = (const float*)d_in[13];
    p.out = (float*)d_out; p.ws = (unsigned char*)d_ws;
    if (hipMemsetAsync((char*)d_ws + WS_BAR, 0, 16384, stream) != hipSuccess) { fprintf(stderr, "kernel_launch: memset failed\n"); return; }
    hipLaunchKernelGGL(fwd_mega, dim3(grid_blocks), dim3(NTHR), LDS_BYTES, stream, p);
    const hipError_t e = hipPeekAtLastError();
    if (e != hipSuccess) fprintf(stderr, "kernel_launch: launch failed: %s (grid %d)\n", hipGetErrorString(e), grid_blocks);
}
```

```cpp
#include <hip/hip_runtime.h>
#include <cstdio>
#include <cstdint>
namespace pg8 {
#define PG8_LAS __attribute__((address_space(3)))
typedef unsigned short bf16_t;
typedef short bf16x8 __attribute__((ext_vector_type(8)));
typedef float f32x4 __attribute__((ext_vector_type(4)));
typedef unsigned u32x4 __attribute__((ext_vector_type(4)));
constexpr int BM = 256, BK = 64, HALF = 128, HTB = HALF * BK * 2  , STAGE_BYTES = 8 * HTB, NXCD = 8, WGM = 8;

__host__ __device__ __forceinline__ int lds_byte(int r, int c) { const int st = (r >> 4) * 2 + (c >> 5), rr = r & 15, cc = c & 31, ob = rr * 64 + cc * 2; return st * 1024 + (ob ^ (((ob >> 9) & 1) << 5)); }
__host__ __device__ __forceinline__ void stage_rc(int b, int& R, int& C) { const int st = b / 1024, sb = b % 1024, swz = sb ^ (((sb >> 9) & 1) << 5); R = (st >> 1) * 16 + swz / 64; C = (st & 1) * 32 + (swz % 64) / 2; }
__host__ __device__ __forceinline__ int perm32(int rho) { const int n = rho >> 4, i = rho & 15; return 8 * (i >> 2) + 4 * n + (i & 3); }

struct Unit { int pm, pn; };
struct Gemm { const bf16_t* A; const bf16_t* Bt; int M, N, K; };

struct StaticOrder {
    int nM, nN, nwg, G, c;
    __host__ __device__ void init(int M, int N, int G_, int c_) { nM = M / BM; nN = N / BM; nwg = nM * nN; G = G_; c = c_; }
    __host__ __device__ bool next(int i, Unit& u) const {
        const long L = (long)i * G + c; if (L >= nwg) return false;
        int wgid = (int)L; { const int q = nwg / NXCD, r = nwg % NXCD, xcd = wgid % NXCD, off = wgid / NXCD; wgid = (xcd < r ? xcd * (q + 1) : r * (q + 1) + (xcd - r) * q) + off; }
        const int nig = WGM * nN, gid = wgid / nig, fm = gid * WGM, gsz = (nM - fm) < WGM ? (nM - fm) : WGM;
        u.pm = fm + ((wgid % nig) % gsz); u.pn = (wgid % nig) / gsz; return true;
    }
    __device__ __forceinline__ void a_ready(const Unit&) const {}
    __device__ __forceinline__ void done(const Unit&) const {}
};
__device__ __forceinline__ unsigned cvt_pk_bf16(float lo, float hi) { unsigned r; asm volatile("v_cvt_pk_bf16_f32 %0, %1, %2" : "=v"(r) : "v"(lo), "v"(hi)); return r; }
typedef float f32x2 __attribute__((ext_vector_type(2)));

__device__ __forceinline__ float sigm(float v) { return __builtin_amdgcn_rcpf(1.0f + __expf(-v)); }
__device__ __forceinline__ float silu(float v) { return v * sigm(v); }
constexpr size_t PSEC = (size_t)16 * 2048 * 512;
struct EpiProj {
    static constexpr bool PERM = true, AFTER_DRAIN = false;
    bf16_t* P;
    __device__ __forceinline__ void operator()(const f32x4 (&acc)[2][2][4][2], const Unit& u, int wr, int wc, int fr, int fq) const {
        const int row0 = u.pm * BM + wr * 64 + fr; const int pn = u.pn;
        if (pn >= 4 && pn < 8) {
            const int col0 = 128 * (pn - 4) + wc * 32 + 8 * fq; bf16_t* Ps = P + (size_t)2 * PSEC;
#pragma unroll
            for (int ai = 0; ai < 2; ++ai)
#pragma unroll
                for (int m = 0; m < 4; ++m) { bf16_t* rowp = Ps + (size_t)(row0 + ai * HALF + m * 16) * 512 + col0;
                    const f32x4 v0 = acc[ai][0][m][0], v1 = acc[ai][0][m][1], g0 = acc[ai][1][m][0], g1 = acc[ai][1][m][1];
                    u32x4 w; w.x = cvt_pk_bf16(v0[0] * sigm(g0[0]), v0[1] * sigm(g0[1])); w.y = cvt_pk_bf16(v0[2] * sigm(g0[2]), v0[3] * sigm(g0[3]));
                    w.z = cvt_pk_bf16(v1[0] * sigm(g1[0]), v1[1] * sigm(g1[1])); w.w = cvt_pk_bf16(v1[2] * sigm(g1[2]), v1[3] * sigm(g1[3]));
                    *(u32x4*)rowp = w; }
        } else {
            const int sec = pn < 2 ? 0 : (pn < 4 ? 1 : 3), colbase = 256 * (pn & 1); const bool act = pn >= 2;
            const int col0 = colbase + wc * 32 + 8 * fq; bf16_t* Ps = P + (size_t)sec * PSEC;
#pragma unroll
            for (int ai = 0; ai < 2; ++ai)
#pragma unroll
                for (int m = 0; m < 4; ++m) { bf16_t* rowp = Ps + (size_t)(row0 + ai * HALF + m * 16) * 512 + col0;
#pragma unroll
                    for (int bj = 0; bj < 2; ++bj) { f32x4 v0 = acc[ai][bj][m][0], v1 = acc[ai][bj][m][1];
                        if (act) {
#pragma unroll
                            for (int j = 0; j < 4; ++j) { v0[j] = silu(v0[j]); v1[j] = silu(v1[j]); } }
                        u32x4 w; w.x = cvt_pk_bf16(v0[0], v0[1]); w.y = cvt_pk_bf16(v0[2], v0[3]); w.z = cvt_pk_bf16(v1[0], v1[1]); w.w = cvt_pk_bf16(v1[2], v1[3]);
                        *(u32x4*)(rowp + bj * HALF) = w; } }
        }
    }
};
__device__ __forceinline__ float bf_lo(unsigned w) { return __uint_as_float(w << 16); }
__device__ __forceinline__ float bf_hi(unsigned w) { return __uint_as_float(w & 0xffff0000u); }
struct EpiPw {
    static constexpr bool PERM = true, AFTER_DRAIN = false;
    const bf16_t* P; bf16_t* Y; const float* bias;
    __device__ __forceinline__ void operator()(const f32x4 (&acc)[2][2][4][2], const Unit& u, int wr, int wc, int fr, int fq) const {
        const int row0 = u.pm * BM + wr * 64 + fr; const int col0 = u.pn * BM + wc * 32 + 8 * fq;
        f32x4 bv[2][2];
#pragma unroll
        for (int bj = 0; bj < 2; ++bj)
#pragma unroll
            for (int n = 0; n < 2; ++n) bv[bj][n] = *(const f32x4*)(bias + col0 + bj * HALF + 4 * n);
#pragma unroll
        for (int ai = 0; ai < 2; ++ai)
#pragma unroll
            for (int m = 0; m < 4; ++m) { const size_t row = (size_t)(row0 + ai * HALF + m * 16);
#pragma unroll
                for (int bj = 0; bj < 2; ++bj) { const u32x4 gt = *(const u32x4*)(P + 3 * PSEC + row * 512 + col0 + bj * HALF);
                    const f32x4 v0 = acc[ai][bj][m][0] + bv[bj][0], v1 = acc[ai][bj][m][1] + bv[bj][1];
                    u32x4 w; w.x = cvt_pk_bf16(v0[0] * bf_lo(gt.x), v0[1] * bf_hi(gt.x)); w.y = cvt_pk_bf16(v0[2] * bf_lo(gt.y), v0[3] * bf_hi(gt.y));
                    w.z = cvt_pk_bf16(v1[0] * bf_lo(gt.z), v1[1] * bf_hi(gt.z)); w.w = cvt_pk_bf16(v1[2] * bf_lo(gt.w), v1[3] * bf_hi(gt.w));
                    *(u32x4*)(Y + row * 1024 + 512 + col0 + bj * HALF) = w; } }
    }
};
struct EpiDelta {
    static constexpr bool PERM = true, AFTER_DRAIN = false;
    bf16_t* O;
    __device__ __forceinline__ void operator()(const f32x4 (&acc)[2][2][4][2], const Unit& u, int wr, int wc, int fr, int fq) const {
        const int row0 = u.pm * BM + wr * 64 + fr; const int col0 = u.pn * BM + wc * 32 + 8 * fq;
#pragma unroll
        for (int ai = 0; ai < 2; ++ai)
#pragma unroll
            for (int m = 0; m < 4; ++m) { bf16_t* rowp = O + (size_t)(row0 + ai * HALF + m * 16) * 1024 + col0;
#pragma unroll
                for (int bj = 0; bj < 2; ++bj) { const f32x4 v0 = acc[ai][bj][m][0], v1 = acc[ai][bj][m][1];
                    u32x4 w; w.x = cvt_pk_bf16(v0[0], v0[1]); w.y = cvt_pk_bf16(v0[2], v0[3]); w.z = cvt_pk_bf16(v1[0], v1[1]); w.w = cvt_pk_bf16(v1[2], v1[3]);
                    *(u32x4*)(rowp + bj * HALF) = w; } }
    }
};

template <class Epi, class Sched, bool ALIGN_EPI = false, bool SP2 = false>
__device__ __forceinline__ void gemm_phase(PG8_LAS unsigned char* lds, const Gemm g, const Sched& S, const Epi& E) {
    int tid_ = threadIdx.x; asm volatile("" : "+v"(tid_));
    const int tid = tid_, wid = __builtin_amdgcn_readfirstlane(tid >> 6), lane = tid & 63, wr = wid >> 2, wc = wid & 3, fr = lane & 15, fq = lane >> 4;
    const int K = g.K, nt = K / BK;
    unsigned voffA[2], voffB[2];
#pragma unroll
    for (int i = 0; i < 2; ++i) { int R, C; stage_rc(tid * 16 + i * 8192, R, C); const int Rb = Epi::PERM ? ((R & ~31) + perm32(R & 31)) : R;
        voffA[i] = (unsigned)(R * K + C) * 2u; voffB[i] = (unsigned)(Rb * K + C) * 2u; }
    const size_t kstep = (size_t)(BK * 2);
    const size_t hstep = (size_t)HALF * K * 2;
    const size_t tstep = 2 * hstep;
    const unsigned ldsw = (unsigned)wid * 1024u;
    const int aoff = lds_byte(wr * 64 + fr, fq * 8), boff = lds_byte(wc * 32 + fr, fq * 8);
#define PG8_SA(b, h) (((b) * 2 + (h)) * HTB)
#define PG8_SB(b, h) ((4 + (b) * 2 + (h)) * HTB)
#define PG8_STAGE(bufoff, gbase, voff) do { _Pragma("unroll") for (int _i = 0; _i < 2; ++_i) \
        __builtin_amdgcn_global_load_lds((const unsigned*)((const char*)(gbase) + (voff)[_i]), (PG8_LAS unsigned*)(lds + (bufoff) + ldsw + _i * 8192), 16, 0, 0); } while (0)
#define PG8_LDA(dst, b, h) do { _Pragma("unroll") for (int m = 0; m < 4; ++m) _Pragma("unroll") for (int k = 0; k < 2; ++k) dst[m][k] = *(const PG8_LAS bf16x8*)(lds + PG8_SA(b, h) + aoff + m * 2048 + k * 1024); } while (0)
#define PG8_LDB(dst, b, h) do { _Pragma("unroll") for (int n = 0; n < 2; ++n) _Pragma("unroll") for (int k = 0; k < 2; ++k) dst[n][k] = *(const PG8_LAS bf16x8*)(lds + PG8_SB(b, h) + boff + n * 2048 + k * 1024); } while (0)
#define PG8_MMA(ai, bj, At, Bt) do { __builtin_amdgcn_s_setprio(1); _Pragma("unroll") for (int m = 0; m < 4; ++m) _Pragma("unroll") for (int n = 0; n < 2; ++n) _Pragma("unroll") for (int k = 0; k < 2; ++k) \
        acc[ai][bj][m][n] = __builtin_amdgcn_mfma_f32_16x16x32_bf16(Bt[n][k], At[m][k], acc[ai][bj][m][n], 0, 0, 0); __builtin_amdgcn_s_setprio(0); } while (0)
#define PG8_WAIT_V(n) asm volatile("s_waitcnt vmcnt(" #n ")" ::: "memory")
#define PG8_WAIT_L(n) asm volatile("s_waitcnt lgkmcnt(" #n ")" ::: "memory")
#define PG8_BAR __builtin_amdgcn_s_barrier()
#define PG8_SCHED __builtin_amdgcn_sched_barrier(0)
    Unit cur, nxt; int ui = 0;
    if (!S.next(0, cur)) return;
    f32x4 acc[2][2][4][2];
#pragma unroll
    for (int a = 0; a < 2; ++a)
#pragma unroll
        for (int b = 0; b < 2; ++b)
#pragma unroll
            for (int m = 0; m < 4; ++m)
#pragma unroll
                for (int n = 0; n < 2; ++n) acc[a][b][m][n] = (f32x4){0.f, 0.f, 0.f, 0.f};
    bf16x8 At[4][2], B0[2][2], B1[2][2];
    const char* cA = (const char*)g.A + (size_t)cur.pm * tstep; const char* cB = (const char*)g.Bt + (size_t)cur.pn * tstep;
    S.a_ready(cur);
    if constexpr (SP2) {
        PG8_STAGE(PG8_SB(0, 0), cB, voffB); PG8_STAGE(PG8_SB(0, 1), cB + hstep, voffB); PG8_STAGE(PG8_SA(0, 0), cA, voffA); PG8_STAGE(PG8_SA(0, 1), cA + hstep, voffA);
        if (wr == 1) PG8_BAR;
        PG8_WAIT_V(2); PG8_BAR;
        PG8_STAGE(PG8_SB(1, 0), cB + kstep, voffB); PG8_STAGE(PG8_SA(1, 0), cA + kstep, voffA); PG8_STAGE(PG8_SB(1, 1), cB + hstep + kstep, voffB);
        PG8_WAIT_V(6); PG8_BAR;
    } else {
        PG8_STAGE(PG8_SB(0, 0), cB, voffB); PG8_STAGE(PG8_SA(0, 0), cA, voffA); PG8_STAGE(PG8_SB(0, 1), cB + hstep, voffB); PG8_STAGE(PG8_SA(0, 1), cA + hstep, voffA);
        if (wr == 1) PG8_BAR;
        PG8_WAIT_V(4); PG8_BAR;
        PG8_STAGE(PG8_SB(1, 0), cB + kstep, voffB); PG8_STAGE(PG8_SA(1, 0), cA + kstep, voffA); PG8_STAGE(PG8_SB(1, 1), cB + hstep + kstep, voffB);
        PG8_WAIT_V(6); PG8_BAR;
    }
    for (;;) {
        const bool has_next = S.next(ui + 1, nxt);
        const char* nA = has_next ? (const char*)g.A + (size_t)nxt.pm * tstep : cA; const char* nB = has_next ? (const char*)g.Bt + (size_t)nxt.pn * tstep : cB;
        for (int t = 0; t < nt; t += 2) {
            const bool last = (t == nt - 2);
            const char* a1 = cA + (size_t)(t + 1) * kstep;
            const char* a2 = last ? nA : cA + (size_t)(t + 2) * kstep; const char* b2 = last ? nB : cB + (size_t)(t + 2) * kstep;
            const char* a3 = a2 + kstep; const char* b3 = b2 + kstep;
            if (last && has_next) S.a_ready(nxt);
            if constexpr (SP2) {
            PG8_LDB(B0, 0, 0); PG8_LDB(B1, 0, 1); PG8_SCHED; PG8_LDA(At, 0, 0); PG8_STAGE(PG8_SA(1, 1), a1 + hstep, voffA);
            PG8_WAIT_V(8); PG8_WAIT_L(0); PG8_BAR; PG8_MMA(0, 0, At, B0); PG8_MMA(0, 1, At, B1); PG8_BAR; PG8_SCHED;
            PG8_LDA(At, 0, 1); PG8_STAGE(PG8_SB(0, 0), b2, voffB); PG8_STAGE(PG8_SB(0, 1), b2 + hstep, voffB); PG8_STAGE(PG8_SA(0, 0), a2, voffA);
            PG8_WAIT_V(8); PG8_WAIT_L(0); PG8_BAR; PG8_MMA(1, 0, At, B0); PG8_MMA(1, 1, At, B1); PG8_BAR; PG8_SCHED;
            PG8_LDB(B0, 1, 0); PG8_LDB(B1, 1, 1); PG8_SCHED; PG8_LDA(At, 1, 0); PG8_STAGE(PG8_SA(0, 1), a2 + hstep, voffA);
            PG8_WAIT_V(8); PG8_WAIT_L(0); PG8_BAR; PG8_MMA(0, 0, At, B0); PG8_MMA(0, 1, At, B1); PG8_BAR; PG8_SCHED;
            PG8_LDA(At, 1, 1); PG8_STAGE(PG8_SB(1, 0), b3, voffB); PG8_STAGE(PG8_SB(1, 1), b3 + hstep, voffB); PG8_STAGE(PG8_SA(1, 0), a3, voffA);
            PG8_WAIT_V(8); PG8_WAIT_L(0); PG8_BAR; PG8_MMA(1, 0, At, B0); PG8_MMA(1, 1, At, B1); PG8_BAR; PG8_SCHED;
            } else {
            PG8_LDB(B0, 0, 0); PG8_SCHED; PG8_LDA(At, 0, 0); PG8_STAGE(PG8_SA(1, 1), a1 + hstep, voffA);
            PG8_WAIT_L(8); PG8_BAR; PG8_WAIT_L(0); PG8_MMA(0, 0, At, B0); PG8_BAR; PG8_SCHED;
            PG8_LDB(B1, 0, 1); PG8_STAGE(PG8_SB(0, 0), b2, voffB);
            PG8_BAR; PG8_WAIT_L(0); PG8_MMA(0, 1, At, B1); PG8_BAR;
            PG8_LDA(At, 0, 1); PG8_STAGE(PG8_SA(0, 0), a2, voffA);
            PG8_BAR; PG8_WAIT_L(0); PG8_MMA(1, 0, At, B0); PG8_BAR; PG8_SCHED;
            PG8_STAGE(PG8_SB(0, 1), b2 + hstep, voffB);
            PG8_WAIT_V(6); PG8_BAR; PG8_MMA(1, 1, At, B1); PG8_BAR;
            PG8_LDB(B0, 1, 0); PG8_SCHED; PG8_LDA(At, 1, 0); PG8_STAGE(PG8_SA(0, 1), a2 + hstep, voffA);
            PG8_WAIT_L(8); PG8_BAR; PG8_WAIT_L(0); PG8_MMA(0, 0, At, B0); PG8_BAR; PG8_SCHED;
            PG8_LDB(B1, 1, 1); PG8_STAGE(PG8_SB(1, 0), b3, voffB);
            PG8_BAR; PG8_WAIT_L(0); PG8_MMA(0, 1, At, B1); PG8_BAR;
            PG8_LDA(At, 1, 1); PG8_STAGE(PG8_SA(1, 0), a3, voffA);
            PG8_BAR; PG8_WAIT_L(0); PG8_MMA(1, 0, At, B0); PG8_BAR; PG8_SCHED;
            PG8_STAGE(PG8_SB(1, 1), b3 + hstep, voffB);
            PG8_WAIT_V(6); PG8_BAR; PG8_MMA(1, 1, At, B1); PG8_BAR;
            }
        }
        if constexpr (ALIGN_EPI) { if (wr == 0) PG8_BAR; }
        if constexpr (!Epi::AFTER_DRAIN) { E(acc, cur, wr, wc, fr, fq); S.done(cur); }
        if (!has_next) break;
#pragma unroll
        for (int a = 0; a < 2; ++a)
#pragma unroll
            for (int b = 0; b < 2; ++b)
#pragma unroll
                for (int m = 0; m < 4; ++m)
#pragma unroll
                    for (int n = 0; n < 2; ++n) acc[a][b][m][n] = (f32x4){0.f, 0.f, 0.f, 0.f};
        cur = nxt; cA = nA; cB = nB; ++ui;
        if constexpr (ALIGN_EPI) { if (wr == 1) PG8_BAR; }
    }
    PG8_WAIT_V(0);
    if constexpr (!ALIGN_EPI) { if (wr == 0) PG8_BAR; }
    PG8_BAR;
    if constexpr (Epi::AFTER_DRAIN) { E.fused(acc, cur, wr, wc, fr, fq, lds, wid, lane); S.done(cur); }
#undef PG8_SA
#undef PG8_SB
#undef PG8_STAGE
#undef PG8_LDA
#undef PG8_LDB
#undef PG8_MMA
#undef PG8_WAIT_V
#undef PG8_WAIT_L
#undef PG8_BAR
#undef PG8_SCHED
}
}

constexpr int MTOK = 16 * 2048, SEQ = 2048, DM = 1024, DIN = 2560, WP = 512, WC = 512;
constexpr int MISC_OFF = 131072, LDS_BYTES = 131072 + 256, NTHR = 512;
constexpr size_t WS_WIN = 0, WS_PW = WS_WIN + (size_t)DIN * DM * 2, WS_WOUT = WS_PW + (size_t)WC * WC * 2, WS_HN = WS_WOUT + (size_t)DM * DM * 2,
                 WS_P = WS_HN + (size_t)MTOK * DM * 2, WS_HC = WS_P + (size_t)MTOK * 2048 * 2, WS_Y = WS_HC + (size_t)MTOK * WC * 2, WS_PART = WS_Y + (size_t)MTOK * DM * 2,
                 WS_BAR = WS_PART + (size_t)MTOK * 16 * 4, WS_DELTA = WS_HN  , WS_END = WS_BAR + 16384;
#define LAS __attribute__((address_space(3)))
typedef unsigned short bf16;
typedef float f32x4 __attribute__((ext_vector_type(4)));
typedef float f32x2 __attribute__((ext_vector_type(2)));
typedef unsigned u32x4 __attribute__((ext_vector_type(4)));
typedef unsigned u32x2 __attribute__((ext_vector_type(2)));
#define LDS_WAIT() asm volatile("s_waitcnt lgkmcnt(0)" ::: "memory")
using pg8::cvt_pk_bf16; using pg8::silu; using pg8::bf_lo; using pg8::bf_hi;

#define RLX_AGENT __ATOMIC_RELAXED, __HIP_MEMORY_SCOPE_AGENT
#define XB_TMO      128
#define XB_XCNT(j)  (256  + 64 * (j))
#define XB_XSUB(j)  (1280 + 64 * (j))
#define XB_XGEN(j)  (2304 + 64 * (j))
#define XB_TOP      3328
#define XB_TOPGEN   3392
#define XCD_BAR_WORDS 3456
#define XB_SPIN_CAP (1u << 18)

__device__ __forceinline__ unsigned xb_ld(unsigned* p)              { return __hip_atomic_load(p, __ATOMIC_RELAXED, __HIP_MEMORY_SCOPE_AGENT); }
__device__ __forceinline__ unsigned xb_add(unsigned* p, unsigned v) { return __hip_atomic_fetch_add(p, v, __ATOMIC_RELAXED, __HIP_MEMORY_SCOPE_AGENT); }
__device__ __forceinline__ unsigned xb_xcc_id() { return (unsigned)__builtin_amdgcn_s_getreg((3 << 11) | 20) & 0xFu; }
#define XB_SPIN(cond, bar) do { unsigned _sp = 0; while (cond) { __builtin_amdgcn_s_sleep(1); \
    if ((++_sp & 255u) == 0u) { if (xb_ld(&(bar)[XB_TMO])) break; if (_sp > XB_SPIN_CAP) { atomicAdd(&(bar)[XB_TMO], 1u); break; } } } } while (0)

struct XcdBarrier {
    unsigned* bar; unsigned x;
    volatile LAS unsigned* st;
};

__device__ __forceinline__ XcdBarrier xcd_barrier_post(unsigned* bar, volatile LAS unsigned* st) {
    XcdBarrier b; b.bar = bar; b.x = xb_xcc_id(); b.st = st;
    if (threadIdx.x == 0) (void)xb_add(&bar[XB_XCNT(b.x)], 1u);
    return b;
}
__device__ __forceinline__ void xcd_barrier_complete(unsigned* bar, unsigned x, unsigned& nloc, unsigned& nx) {
    const unsigned G = gridDim.x * gridDim.y * gridDim.z;
    unsigned sum, cnt, mine, sp = 0u;
    for (;;) {
        sum = 0u; cnt = 0u; mine = 0u;
#pragma unroll
        for (unsigned j = 0; j < 16; ++j) { const unsigned c = xb_ld(&bar[XB_XCNT(j)]); sum += c; cnt += (c > 0u) ? 1u : 0u; mine = (j == x) ? c : mine; }
        if (sum == G) break;
        __builtin_amdgcn_s_sleep(1);
        if ((++sp & 255u) == 0u) { if (xb_ld(&bar[XB_TMO])) break; if (sp > XB_SPIN_CAP) { atomicAdd(&bar[XB_TMO], 1u); break; } }
    }
    nloc = mine > 0u ? mine : 1u; nx = cnt > 0u ? cnt : 1u;
}

__device__ __forceinline__ void xcd_barrier(const XcdBarrier& b) {
    asm volatile("s_waitcnt vmcnt(0)" ::: "memory");
    __syncthreads();
    if (threadIdx.x == 0) {
        unsigned* bar = b.bar;
        __builtin_amdgcn_s_waitcnt(0);
        unsigned nloc = b.st[0], nx = b.st[1];
        if (nloc == 0u) { xcd_barrier_complete(bar, b.x, nloc, nx); b.st[0] = nloc; b.st[1] = nx; }
        const unsigned old = xb_add(&bar[XB_XSUB(b.x)], 1u);
        const unsigned gen = old / nloc;
        if (old + 1u == (gen + 1u) * nloc) {
            __builtin_amdgcn_fence(__ATOMIC_RELEASE, "agent");
            asm volatile("s_waitcnt vmcnt(0)" ::: "memory");
            const unsigned og = xb_add(&bar[XB_TOP], 1u);
            const unsigned tg = og / nx;
            if (og + 1u == (tg + 1u) * nx) xb_add(&bar[XB_TOPGEN], 1u);
            else XB_SPIN(xb_ld(&bar[XB_TOPGEN]) == tg, bar);
            __builtin_amdgcn_fence(__ATOMIC_ACQUIRE, "agent");
            xb_add(&bar[XB_XGEN(b.x)], 1u);
            asm volatile("s_waitcnt vmcnt(0)" ::: "memory");
        } else {
            XB_SPIN(xb_ld(&bar[XB_XGEN(b.x)]) == gen, bar);
            __builtin_amdgcn_fence(__ATOMIC_ACQUIRE, "agent");
            asm volatile("s_waitcnt vmcnt(0)" ::: "memory");
        }
    }
    __syncthreads();
}

struct Params {
    const float *x, *norm_g, *w_in, *pool_w, *pool_b, *pool_scale, *conv_dw, *conv_b, *ln_g, *ln_b, *pw_w, *pw_b, *w_out, *final_g;
    float* out; unsigned char* ws;
};

__device__ __forceinline__ float wave_sum(float v) {
#pragma unroll
    for (int o = 1; o < 64; o <<= 1) v += __shfl_xor(v, o);
    return v;
}
__device__ __forceinline__ float wave_sum_dpp(float v) {
#define DPP_ADD(ctrl) v += __builtin_bit_cast(float, __builtin_amdgcn_update_dpp(0, __builtin_bit_cast(int, v), (ctrl), 0xf, 0xf, true))
    DPP_ADD(0xB1);
    DPP_ADD(0x4E);
    DPP_ADD(0x141);
    DPP_ADD(0x140);
#undef DPP_ADD
    const int b = __builtin_bit_cast(int, v);
    return (__builtin_bit_cast(float, __builtin_amdgcn_readlane(b, 0)) + __builtin_bit_cast(float, __builtin_amdgcn_readlane(b, 16))) + (__builtin_bit_cast(float, __builtin_amdgcn_readlane(b, 32)) + __builtin_bit_cast(float, __builtin_amdgcn_readlane(b, 48)));
}
__device__ __forceinline__ void transpose_item(const float* W, int ldw, int scol0, int k0, bf16* WT, int ldt, int drow0, LAS float* scr, int lane) {
    float tv[32];
#pragma unroll
    for (int i = 0; i < 32; ++i) tv[i] = W[(size_t)(k0 + 2 * i + (lane >> 5)) * ldw + scol0 + (lane & 31)];
#pragma unroll
    for (int i = 0; i < 32; ++i) scr[(2 * i + (lane >> 5)) * 33 + (lane & 31)] = tv[i];
    LDS_WAIT();
    const int c = lane & 7;
#pragma unroll
    for (int j = 0; j < 4; ++j) { const int n = (lane >> 3) + 8 * j; const LAS float* s = scr + (8 * c) * 33 + n;
        u32x4 o; o.x = cvt_pk_bf16(s[0 * 33], s[1 * 33]); o.y = cvt_pk_bf16(s[2 * 33], s[3 * 33]); o.z = cvt_pk_bf16(s[4 * 33], s[5 * 33]); o.w = cvt_pk_bf16(s[6 * 33], s[7 * 33]);
        *(u32x4*)(WT + (size_t)(drow0 + n) * ldt + k0 + 8 * c) = o; }
    LDS_WAIT();
}
__device__ __forceinline__ void poolfold_wg(const float* w_in, const float* pool_w, bf16* WinT, int g, int k0, LAS unsigned char* lds, int tid, int wave, int lane) {
    LAS float* pw = (LAS float*)lds;
    LAS float* wi = (LAS float*)(lds + 65536);
    const f32x4* src = (const f32x4*)(pool_w + (size_t)g * 128 * 128) + tid; f32x4 t[8];
#pragma unroll
    for (int i = 0; i < 8; ++i) t[i] = src[i * NTHR];
    const f32x4 wv = *(const f32x4*)(w_in + (size_t)(k0 + (tid >> 5)) * DIN + 128 * g + 4 * (tid & 31));
#pragma unroll
    for (int i = 0; i < 8; ++i) *((LAS f32x4*)pw + tid + i * NTHR) = t[i];
    *((LAS f32x4*)wi + tid) = wv;
    __syncthreads();
    float a00 = 0.f, a01 = 0.f, a10 = 0.f, a11 = 0.f;
    const LAS float* w0 = wi + (2 * wave) * 128; const LAS float* w1 = w0 + 128;
#pragma unroll 4
    for (int c4 = 0; c4 < 32; ++c4) { const f32x4 x0 = *(const LAS f32x4*)(w0 + 4 * c4), x1 = *(const LAS f32x4*)(w1 + 4 * c4);
#pragma unroll
        for (int cc = 0; cc < 4; ++cc) { const float p0 = pw[(4 * c4 + cc) * 128 + lane], p1 = pw[(4 * c4 + cc) * 128 + 64 + lane];
            a00 += x0[cc] * p0; a01 += x0[cc] * p1; a10 += x1[cc] * p0; a11 += x1[cc] * p1; } }
    *(unsigned*)(WinT + (size_t)(128 * g + lane) * DM + k0 + 2 * wave) = cvt_pk_bf16(a00, a10);
    *(unsigned*)(WinT + (size_t)(128 * g + 64 + lane) * DM + k0 + 2 * wave) = cvt_pk_bf16(a01, a11);
    __syncthreads();
}

__device__ __forceinline__ void phase_prep(const Params& p, LAS unsigned char* lds, int bid, int G) {
    int tid_ = threadIdx.x; asm volatile("" : "+v"(tid_)); const int tid = tid_, lane = tid & 63, wave = __builtin_amdgcn_readfirstlane(tid >> 6);
    LAS float* scr = (LAS float*)(lds + wave * 8704);
    bf16* WinT = (bf16*)(p.ws + WS_WIN); bf16* PwT = (bf16*)(p.ws + WS_PW); bf16* WoutT = (bf16*)(p.ws + WS_WOUT); bf16* HN = (bf16*)(p.ws + WS_HN);
    const int gw = bid * 8 + wave, NGW = G * 8;
    for (int t = bid; t < 256; t += G) poolfold_wg(p.w_in, p.pool_w, WinT, t & 3, 16 * (t >> 2), lds, tid, wave, lane);
    if (wave < 2) for (int t = bid + G * wave; t < 1664; t += 2 * G) {
        if (t < 1024) { const int kb = t >> 6, nb = t & 63, n = 512 + 32 * nb; int scol;
            if (n < 1024 || n >= 2048) scol = n; else { const int q = (n - 1024) >> 8, r = (n - 1024) & 255; scol = r < 128 ? 1024 + 128 * q + r : 1536 + 128 * q + (r - 128); }
            transpose_item(p.w_in, DIN, scol, 64 * kb, WinT, DM, n, scr, lane); }
        else if (t < 1152) { const int it = t - 1024, kb = it >> 4, nb = it & 15; transpose_item(p.pw_w, WC, 32 * nb, 64 * kb, PwT, WC, 32 * nb, scr, lane); }
        else { const int it = t - 1152, kb = it >> 5, nb = it & 31; transpose_item(p.w_out, DM, 32 * nb, 64 * kb, WoutT, DM, 32 * nb, scr, lane); }
    }
    f32x4 gv[4];
#pragma unroll
    for (int j = 0; j < 4; ++j) gv[j] = *((const f32x4*)p.norm_g + lane + 64 * j);
    LAS int* ticket = (LAS int*)(lds + MISC_OFF + 64);
    for (;;) {
        int c = 0; if (lane == 0) c = __hip_atomic_fetch_add(ticket, 1, __ATOMIC_RELAXED, __HIP_MEMORY_SCOPE_WORKGROUP);
        c = __builtin_amdgcn_readfirstlane(c);
        const int m0 = 4 * (bid + G * c); if (m0 >= MTOK) break;
        const f32x4* xr = (const f32x4*)(p.x + (size_t)m0 * DM) + lane; f32x4 v[4][4];
#pragma unroll
        for (int r = 0; r < 4; ++r)
#pragma unroll
            for (int j = 0; j < 4; ++j) v[r][j] = xr[r * 256 + 64 * j];
        __builtin_amdgcn_sched_barrier(0);
#pragma unroll
        for (int r = 0; r < 4; ++r) { float s = 0.f;
#pragma unroll
            for (int j = 0; j < 4; ++j) s += (v[r][j].x * v[r][j].x + v[r][j].y * v[r][j].y) + (v[r][j].z * v[r][j].z + v[r][j].w * v[r][j].w);
            const float rs = 1.0f / sqrtf(wave_sum_dpp(s) * (1.0f / DM) + 1e-6f);
            u32x2* o8 = (u32x2*)(HN + (size_t)(m0 + r) * DM) + lane;
#pragma unroll
            for (int j = 0; j < 4; ++j) { const f32x4 y = v[r][j] * rs * gv[j]; u32x2 w; w.x = cvt_pk_bf16(y.x, y.y); w.y = cvt_pk_bf16(y.z, y.w); o8[64 * j] = w; } }
    }
}

__device__ __forceinline__ void mixer_load_h(const bf16* P, int tile, int wave, int lane, u32x4 (&hv)[8]) {
    const int t0 = tile * 32, s0 = t0 & (SEQ - 1);
#pragma unroll
    for (int k = 0; k < 8; ++k) { const int r = wave + 8 * k; const bool ok = (s0 - 30 + r >= 0) && (r < 62);
        const u32x4 v = *(const u32x4*)(P + 2 * pg8::PSEC + (size_t)(ok ? t0 - 30 + r : t0) * 512 + lane * 8);
        hv[k] = ok ? v : (u32x4){0u, 0u, 0u, 0u}; }
}
#define GAS __attribute__((address_space(1)))
#define FMAC(acc, x_, y_) asm("v_fmac_f32 %0, %1, %2" : "+v"(acc) : "v"(x_), "v"(y_))
template <int W> __device__ __forceinline__ void pool_compute(const unsigned (&ur)[31], const unsigned (&ag)[16], int sa, f32x2 pb, f32x2 ps, bf16* yp) {
    float s0 = 0.f, s1 = 0.f;
#pragma unroll
    for (int i = 16 - W; i <= 15; ++i) { s0 += bf_lo(ur[i]); s1 += bf_hi(ur[i]); }
#pragma unroll
    for (int r = 0; r < 16; ++r) {
        if (r > 0) { s0 += bf_lo(ur[15 + r]) - bf_lo(ur[15 + r - W]); s1 += bf_hi(ur[15 + r]) - bf_hi(ur[15 + r - W]); }
        const int cnt = sa + r + 1 < W ? sa + r + 1 : W; const float inv = 1.0f / (float)cnt;
        const float z0 = s0 * inv - bf_lo(ur[15 + r]) + pb.x, z1 = s1 * inv - bf_hi(ur[15 + r]) + pb.y;
        *(unsigned*)(yp + (size_t)r * DM) = cvt_pk_bf16(z0 * ps.x * bf_lo(ag[r]), z1 * ps.y * bf_hi(ag[r]));
    }
}
__device__ __forceinline__ void phase_mixer(const Params& p, LAS unsigned char* lds, int bid, int G) {
    int tid_ = threadIdx.x; asm volatile("" : "+v"(tid_)); const int tid = tid_, lane = tid & 63, wave = __builtin_amdgcn_readfirstlane(tid >> 6);
    const bf16* P = (const bf16*)(p.ws + WS_P); bf16* HC = (bf16*)(p.ws + WS_HC); bf16* Y = (bf16*)(p.ws + WS_Y);
    LAS unsigned char* Hs = lds;
    LAS float* Cs = (LAS float*)(lds + 62 * 1024);
    const int cp = tid & 255, th = tid >> 8;
    const int pgp = wave & 3, pth = wave >> 2, pw_ = 2 << pgp, pc0 = 128 * pgp + 2 * lane;
    const f32x2 pb = *(const f32x2*)(p.pool_b + pc0), ps = *(const f32x2*)(p.pool_scale + pc0);
    const f32x4 lg0 = *(const f32x4*)(p.ln_g + 4 * lane), lg1 = *(const f32x4*)(p.ln_g + 256 + 4 * lane), lb0 = *(const f32x4*)(p.ln_b + 4 * lane), lb1 = *(const f32x4*)(p.ln_b + 256 + 4 * lane);
    const f32x2 cb = *(const f32x2*)(p.conv_b + 2 * cp);
    const int NT = MTOK / 32;
    f32x2 tw[31];
#pragma unroll
    for (int j = 0; j < 31; ++j) tw[j] = *(const f32x2*)(p.conv_dw + j * WC + 2 * cp);
    u32x4 hv[8];
    if (bid < NT) mixer_load_h(P, bid, wave, lane, hv);
    for (int tile = bid; tile < NT; tile += G) {
        const int t0 = tile * 32, s0 = t0 & (SEQ - 1);
        const int ta = t0 + 16 * pth, sa = s0 + 16 * pth;
#pragma unroll
        for (int k = 0; k < 8; ++k) { const int r = wave + 8 * k; if (r < 62) *(LAS u32x4*)(Hs + r * 1024 + lane * 16) = hv[k]; }
        unsigned ur[31], ag[16];
#pragma unroll
        for (int i = 0; i < 31; ++i) { const bool ok = (i >= 16 - pw_) && (sa - 15 + i >= 0);
            const unsigned v = *(const unsigned*)(P + (size_t)(ok ? ta - 15 + i : ta) * 512 + pc0); ur[i] = ok ? v : 0u; }
#pragma unroll
        for (int r = 0; r < 16; ++r) ag[r] = *(const unsigned*)(P + pg8::PSEC + (size_t)(ta + r) * 512 + pc0);
        if (tile + G < NT) mixer_load_h(P, tile + G, wave, lane, hv);
        __builtin_amdgcn_sched_barrier(0);
        __syncthreads();
        {
            float a0[16], a1[16];
#pragma unroll
            for (int r = 0; r < 16; ++r) { a0[r] = cb.x; a1[r] = cb.y; }
            const LAS unsigned* hp = (const LAS unsigned*)(Hs + (th * 16) * 1024 + cp * 4);
#pragma unroll
            for (int i = 0; i < 46; ++i) { const unsigned w = hp[i * 256]; const float v0 = bf_lo(w), v1 = bf_hi(w);
#pragma unroll
                for (int r = 0; r < 16; ++r) { const int j = i - r; if (j >= 0 && j <= 30) { FMAC(a0[r], tw[j].x, v0); FMAC(a1[r], tw[j].y, v1); } } }
#pragma unroll
            for (int r = 0; r < 16; ++r) *(LAS f32x2*)(Cs + (th * 16 + r) * 512 + 2 * cp) = (f32x2){a0[r], a1[r]};
        }
        __builtin_amdgcn_sched_barrier(0);
        __syncthreads();
#pragma unroll
        for (int rr = 0; rr < 4; ++rr) { const int row = 4 * wave + rr;
            f32x4 v0 = *(const LAS f32x4*)(Cs + row * 512 + 4 * lane), v1 = *(const LAS f32x4*)(Cs + row * 512 + 256 + 4 * lane);
            const float mean = wave_sum_dpp((v0.x + v0.y) + (v0.z + v0.w) + (v1.x + v1.y) + (v1.z + v1.w)) * (1.0f / 512.0f);
            v0 = v0 - mean; v1 = v1 - mean;
            const float var = wave_sum_dpp((v0.x * v0.x + v0.y * v0.y) + (v0.z * v0.z + v0.w * v0.w) + (v1.x * v1.x + v1.y * v1.y) + (v1.z * v1.z + v1.w * v1.w)) * (1.0f / 512.0f);
            const float rstd = 1.0f / sqrtf(var + 1e-5f);
            v0 = v0 * rstd * lg0 + lb0; v1 = v1 * rstd * lg1 + lb1;
            u32x2 w0, w1; w0.x = cvt_pk_bf16(silu(v0.x), silu(v0.y)); w0.y = cvt_pk_bf16(silu(v0.z), silu(v0.w)); w1.x = cvt_pk_bf16(silu(v1.x), silu(v1.y)); w1.y = cvt_pk_bf16(silu(v1.z), silu(v1.w));
            bf16* o = HC + (size_t)(t0 + row) * WC; *(u32x2*)(o + 4 * lane) = w0; *(u32x2*)(o + 256 + 4 * lane) = w1; }
        __builtin_amdgcn_sched_barrier(0);
        { bf16* yp = Y + (size_t)ta * DM + pc0;
          if (pgp == 0) pool_compute<2>(ur, ag, sa, pb, ps, yp); else if (pgp == 1) pool_compute<4>(ur, ag, sa, pb, ps, yp);
          else if (pgp == 2) pool_compute<8>(ur, ag, sa, pb, ps, yp); else pool_compute<16>(ur, ag, sa, pb, ps, yp); }
    }
    __syncthreads();
}

__device__ __forceinline__ void phase_final(const Params& p, int bid, int G) {
    int tid_ = threadIdx.x; asm volatile("" : "+v"(tid_)); const int tid = tid_, lane = tid & 63, wave = __builtin_amdgcn_readfirstlane(tid >> 6);
    const bf16* DL = (const bf16*)(p.ws + WS_DELTA);
    const int gw = bid * 8 + wave, NGW = G * 8;
    f32x4 gv[4];
#pragma unroll
    for (int j = 0; j < 4; ++j) gv[j] = *((const f32x4*)p.final_g + lane + 64 * j);
    for (int m0 = gw * 4; m0 < MTOK; m0 += NGW * 4) {
        const f32x4* xr = (const f32x4*)(p.x + (size_t)m0 * DM) + lane; const u32x2* dr = (const u32x2*)(DL + (size_t)m0 * DM) + lane;
        f32x4 v[4][4]; u32x2 d[4][4];
#pragma unroll
        for (int r = 0; r < 4; ++r)
#pragma unroll
            for (int j = 0; j < 4; ++j) { v[r][j] = xr[r * 256 + 64 * j]; d[r][j] = dr[r * 256 + 64 * j]; }
        __builtin_amdgcn_sched_barrier(0);
#pragma unroll
        for (int r = 0; r < 4; ++r) { float s = 0.f;
#pragma unroll
            for (int j = 0; j < 4; ++j) { v[r][j].x += bf_lo(d[r][j].x); v[r][j].y += bf_hi(d[r][j].x); v[r][j].z += bf_lo(d[r][j].y); v[r][j].w += bf_hi(d[r][j].y);
                s += (v[r][j].x * v[r][j].x + v[r][j].y * v[r][j].y) + (v[r][j].z * v[r][j].z + v[r][j].w * v[r][j].w); }
            const float rs = 1.0f / sqrtf(wave_sum_dpp(s) * (1.0f / DM) + 1e-6f);
            f32x4* o = (f32x4*)(p.out + (size_t)(m0 + r) * DM) + lane;
#pragma unroll
            for (int j = 0; j < 4; ++j) o[64 * j] = v[r][j] * rs * gv[j]; }
    }
}

__global__ void __launch_bounds__(NTHR, 2) fwd_mega(Params p) {
    extern __shared__ __attribute__((aligned(16))) unsigned char lds_raw[];
    LAS unsigned char* lds = (LAS unsigned char*)lds_raw;
    const int bid = blockIdx.x, G = gridDim.x;
    const bf16* WinT = (const bf16*)(p.ws + WS_WIN); const bf16* PwT = (const bf16*)(p.ws + WS_PW); const bf16* WoutT = (const bf16*)(p.ws + WS_WOUT);
    const bf16* HN = (const bf16*)(p.ws + WS_HN); bf16* P = (bf16*)(p.ws + WS_P); const bf16* HC = (const bf16*)(p.ws + WS_HC); bf16* Y = (bf16*)(p.ws + WS_Y);
    bf16* DL = (bf16*)(p.ws + WS_DELTA);

    volatile LAS unsigned* MISC = (volatile LAS unsigned*)(lds + MISC_OFF);
    if (threadIdx.x < 64) MISC[threadIdx.x] = 0u;
    __syncthreads();
    XcdBarrier bar = xcd_barrier_post((unsigned*)(p.ws + WS_BAR), MISC + 8);
#define GSYNC() xcd_barrier(bar)
    phase_prep(p, lds, bid, G);
    GSYNC();
    {
        pg8::Gemm g{HN, WinT, MTOK, DIN, DM}; pg8::StaticOrder S; S.init(MTOK, DIN, G, bid);
        pg8::EpiProj E{P};
        pg8::gemm_phase<pg8::EpiProj, pg8::StaticOrder, true, true>(lds, g, S, E);
    }
    GSYNC();
    phase_mixer(p, lds, bid, G);
    GSYNC();
    {
        pg8::Gemm g{HC, PwT, MTOK, WC, WC}; pg8::StaticOrder S; S.init(MTOK, WC, G, bid);
        pg8::EpiPw E{P, Y, p.pw_b};
        pg8::gemm_phase<pg8::EpiPw, pg8::StaticOrder, true, true>(lds, g, S, E);
    }
    GSYNC();
    {
        pg8::Gemm g{Y, WoutT, MTOK, DM, DM}; pg8::StaticOrder S; S.init(MTOK, DM, G, bid);
        pg8::EpiDelta E{DL};
        pg8::gemm_phase<pg8::EpiDelta, pg8::StaticOrder, true, true>(lds, g, S, E);
    }
    GSYNC();
    phase_final(p, bid, G);
}

extern "C" void kernel_launch(void* const* d_in, const int* in_sizes, int n_in, void* d_out, int out_size, void* d_ws, size_t ws_size, hipStream_t stream) {
    static int grid_blocks = 0;
    if (grid_blocks == 0) {
        if (n_in != 14 || in_sizes[0] != MTOK * DM || out_size != MTOK * DM || ws_size < WS_END) { fprintf(stderr, "kernel_launch: unexpected shapes (n_in %d, ws %zu)\n", n_in, ws_size); grid_blocks = -1; return; }
        int dev = 0, cus = 0, per_cu = 0;
        (void)hipGetDevice(&dev); (void)hipDeviceGetAttribute(&cus, hipDeviceAttributeMultiprocessorCount, dev);
        if (hipFuncSetAttribute((const void*)fwd_mega, hipFuncAttributeMaxDynamicSharedMemorySize, LDS_BYTES) != hipSuccess) { fprintf(stderr, "kernel_launch: hipFuncSetAttribute failed\n"); grid_blocks = -1; return; }
        if (hipOccupancyMaxActiveBlocksPerMultiprocessor(&per_cu, (const void*)fwd_mega, NTHR, LDS_BYTES) != hipSuccess || per_cu < 1) { fprintf(stderr, "kernel_launch: occupancy query failed (%d)\n", per_cu); (void)hipGetLastError(); per_cu = 1; }
        if (per_cu > 1) per_cu = 1;
        grid_blocks = cus * per_cu;
    }
    if (grid_blocks < 0) return;
    Params p{};
    p.x = (const float*)d_in[0]; p.norm_g = (const float*)d_in[1]; p.w_in = (const float*)d_in[2]; p.pool_w = (const float*)d_in[3]; p.pool_b = (const float*)d_in[4];
    p.pool_scale = (const float*)d_in[5]; p.conv_dw = (const float*)d_in[6]; p.conv_b = (const float*)d_in[7]; p.ln_g = (const float*)d_in[8]; p.ln_b = (const float*)d_in[9];
    p.pw_w = (const float*)d_in[10]; p.pw_b = (const float*)d_in[11]; p.w_out = (const float*)d_in[12]; p.final_g = (const float*)d_in[13];
    p.out = (float*)d_out; p.ws = (unsigned char*)d_ws;
    if (hipMemsetAsync((char*)d_ws + WS_BAR, 0, 16384, stream) != hipSuccess) { fprintf(stderr, "kernel_launch: memset failed\n"); return; }
    hipLaunchKernelGGL(fwd_mega, dim3(grid_blocks), dim3(NTHR), LDS_BYTES, stream, p);
    const hipError_t e = hipPeekAtLastError();
    if (e != hipSuccess) fprintf(stderr, "kernel_launch: launch failed: %s (grid %d)\n", hipGetErrorString(e), grid_blocks);
}
```

```cpp
#include <hip/hip_runtime.h>
#include <cstdio>
#include <cstdint>
namespace pg8 {
#define PG8_LAS __attribute__((address_space(3)))
typedef unsigned short bf16_t;
typedef short bf16x8 __attribute__((ext_vector_type(8)));
typedef float f32x4 __attribute__((ext_vector_type(4)));
typedef unsigned u32x4 __attribute__((ext_vector_type(4)));
constexpr int BM = 256, BK = 64, HALF = 128, HTB = HALF * BK * 2  , STAGE_BYTES = 8 * HTB, NXCD = 8, WGM = 8;

__host__ __device__ __forceinline__ int lds_byte(int r, int c) { const int st = (r >> 4) * 2 + (c >> 5), rr = r & 15, cc = c & 31, ob = rr * 64 + cc * 2; return st * 1024 + (ob ^ (((ob >> 9) & 1) << 5)); }
__host__ __device__ __forceinline__ void stage_rc(int b, int& R, int& C) { const int st = b / 1024, sb = b % 1024, swz = sb ^ (((sb >> 9) & 1) << 5); R = (st >> 1) * 16 + swz / 64; C = (st & 1) * 32 + (swz % 64) / 2; }
__host__ __device__ __forceinline__ int perm32(int rho) { const int n = rho >> 4, i = rho & 15; return 8 * (i >> 2) + 4 * n + (i & 3); }

struct Unit { int pm, pn; };
struct Gemm { const bf16_t* A; const bf16_t* Bt; int M, N, K; };

struct StaticOrder {
    int nM, nN, nwg, G, c;
    __host__ __device__ void init(int M, int N, int G_, int c_) { nM = M / BM; nN = N / BM; nwg = nM * nN; G = G_; c = c_; }
    __host__ __device__ bool next(int i, Unit& u) const {
        const long L = (long)i * G + c; if (L >= nwg) return false;
        int wgid = (int)L; { const int q = nwg / NXCD, r = nwg % NXCD, xcd = wgid % NXCD, off = wgid / NXCD; wgid = (xcd < r ? xcd * (q + 1) : r * (q + 1) + (xcd - r) * q) + off; }
        const int nig = WGM * nN, gid = wgid / nig, fm = gid * WGM, gsz = (nM - fm) < WGM ? (nM - fm) : WGM;
        u.pm = fm + ((wgid % nig) % gsz); u.pn = (wgid % nig) / gsz; return true;
    }
    __device__ __forceinline__ void a_ready(const Unit&) const {}
    __device__ __forceinline__ void done(const Unit&) const {}
};
__device__ __forceinline__ unsigned cvt_pk_bf16(float lo, float hi) { unsigned r; asm volatile("v_cvt_pk_bf16_f32 %0, %1, %2" : "=v"(r) : "v"(lo), "v"(hi)); return r; }
typedef float f32x2 __attribute__((ext_vector_type(2)));

__device__ __forceinline__ float sigm(float v) { return __builtin_amdgcn_rcpf(1.0f + __expf(-v)); }
__device__ __forceinline__ float silu(float v) { return v * sigm(v); }
constexpr size_t PSEC = (size_t)16 * 2048 * 512;
struct EpiProj {
    static constexpr bool PERM = true, AFTER_DRAIN = false;
    bf16_t* P;
    __device__ __forceinline__ void operator()(const f32x4 (&acc)[2][2][4][2], const Unit& u, int wr, int wc, int fr, int fq) const {
        const int row0 = u.pm * BM + wr * 64 + fr; const int pn = u.pn;
        if (pn >= 4 && pn < 8) {
            const int col0 = 128 * (pn - 4) + wc * 32 + 8 * fq; bf16_t* Ps = P + (size_t)2 * PSEC;
#pragma unroll
            for (int ai = 0; ai < 2; ++ai)
#pragma unroll
                for (int m = 0; m < 4; ++m) { bf16_t* rowp = Ps + (size_t)(row0 + ai * HALF + m * 16) * 512 + col0;
                    const f32x4 v0 = acc[ai][0][m][0], v1 = acc[ai][0][m][1], g0 = acc[ai][1][m][0], g1 = acc[ai][1][m][1];
                    u32x4 w; w.x = cvt_pk_bf16(v0[0] * sigm(g0[0]), v0[1] * sigm(g0[1])); w.y = cvt_pk_bf16(v0[2] * sigm(g0[2]), v0[3] * sigm(g0[3]));
                    w.z = cvt_pk_bf16(v1[0] * sigm(g1[0]), v1[1] * sigm(g1[1])); w.w = cvt_pk_bf16(v1[2] * sigm(g1[2]), v1[3] * sigm(g1[3]));
                    *(u32x4*)rowp = w; }
        } else {
            const int sec = pn < 2 ? 0 : (pn < 4 ? 1 : 3), colbase = 256 * (pn & 1); const bool act = pn >= 2;
            const int col0 = colbase + wc * 32 + 8 * fq; bf16_t* Ps = P + (size_t)sec * PSEC;
#pragma unroll
            for (int ai = 0; ai < 2; ++ai)
#pragma unroll
                for (int m = 0; m < 4; ++m) { bf16_t* rowp = Ps + (size_t)(row0 + ai * HALF + m * 16) * 512 + col0;
#pragma unroll
                    for (int bj = 0; bj < 2; ++bj) { f32x4 v0 = acc[ai][bj][m][0], v1 = acc[ai][bj][m][1];
                        if (act) {
#pragma unroll
                            for (int j = 0; j < 4; ++j) { v0[j] = silu(v0[j]); v1[j] = silu(v1[j]); } }
                        u32x4 w; w.x = cvt_pk_bf16(v0[0], v0[1]); w.y = cvt_pk_bf16(v0[2], v0[3]); w.z = cvt_pk_bf16(v1[0], v1[1]); w.w = cvt_pk_bf16(v1[2], v1[3]);
                        *(u32x4*)(rowp + bj * HALF) = w; } }
        }
    }
};
__device__ __forceinline__ float bf_lo(unsigned w) { return __uint_as_float(w << 16); }
__device__ __forceinline__ float bf_hi(unsigned w) { return __uint_as_float(w & 0xffff0000u); }
struct EpiPw {
    static constexpr bool PERM = true, AFTER_DRAIN = false;
    const bf16_t* P; bf16_t* Y; const float* bias;
    __device__ __forceinline__ void operator()(const f32x4 (&acc)[2][2][4][2], const Unit& u, int wr, int wc, int fr, int fq) const {
        const int row0 = u.pm * BM + wr * 64 + fr; const int col0 = u.pn * BM + wc * 32 + 8 * fq;
        f32x4 bv[2][2];
#pragma unroll
        for (int bj = 0; bj < 2; ++bj)
#pragma unroll
            for (int n = 0; n < 2; ++n) bv[bj][n] = *(const f32x4*)(bias + col0 + bj * HALF + 4 * n);
#pragma unroll
        for (int ai = 0; ai < 2; ++ai)
#pragma unroll
            for (int m = 0; m < 4; ++m) { const size_t row = (size_t)(row0 + ai * HALF + m * 16);
#pragma unroll
                for (int bj = 0; bj < 2; ++bj) { const u32x4 gt = *(const u32x4*)(P + 3 * PSEC + row * 512 + col0 + bj * HALF);
                    const f32x4 v0 = acc[ai][bj][m][0] + bv[bj][0], v1 = acc[ai][bj][m][1] + bv[bj][1];
                    u32x4 w; w.x = cvt_pk_bf16(v0[0] * bf_lo(gt.x), v0[1] * bf_hi(gt.x)); w.y = cvt_pk_bf16(v0[2] * bf_lo(gt.y), v0[3] * bf_hi(gt.y));
                    w.z = cvt_pk_bf16(v1[0] * bf_lo(gt.z), v1[1] * bf_hi(gt.z)); w.w = cvt_pk_bf16(v1[2] * bf_lo(gt.w), v1[3] * bf_hi(gt.w));
                    *(u32x4*)(Y + row * 1024 + 512 + col0 + bj * HALF) = w; } }
    }
};
struct EpiDelta {
    static constexpr bool PERM = true, AFTER_DRAIN = false;
    bf16_t* O;
    __device__ __forceinline__ void operator()(const f32x4 (&acc)[2][2][4][2], const Unit& u, int wr, int wc, int fr, int fq) const {
        const int row0 = u.pm * BM + wr * 64 + fr; const int col0 = u.pn * BM + wc * 32 + 8 * fq;
#pragma unroll
        for (int ai = 0; ai < 2; ++ai)
#pragma unroll
            for (int m = 0; m < 4; ++m) { bf16_t* rowp = O + (size_t)(row0 + ai * HALF + m * 16) * 1024 + col0;
#pragma unroll
                for (int bj = 0; bj < 2; ++bj) { const f32x4 v0 = acc[ai][bj][m][0], v1 = acc[ai][bj][m][1];
                    u32x4 w; w.x = cvt_pk_bf16(v0[0], v0[1]); w.y = cvt_pk_bf16(v0[2], v0[3]); w.z = cvt_pk_bf16(v1[0], v1[1]); w.w = cvt_pk_bf16(v1[2], v1[3]);
                    *(u32x4*)(rowp + bj * HALF) = w; } }
    }
};

template <class Epi, class Sched, bool ALIGN_EPI = false, bool SP2 = false>
__device__ __forceinline__ void gemm_phase(PG8_LAS unsigned char* lds, const Gemm g, const Sched& S, const Epi& E) {
    int tid_ = threadIdx.x; asm volatile("" : "+v"(tid_));
    const int tid = tid_, wid = __builtin_amdgcn_readfirstlane(tid >> 6), lane = tid & 63, wr = wid >> 2, wc = wid & 3, fr = lane & 15, fq = lane >> 4;
    const int K = g.K, nt = K / BK;
    unsigned voffA[2], voffB[2];
#pragma unroll
    for (int i = 0; i < 2; ++i) { int R, C; stage_rc(tid * 16 + i * 8192, R, C); const int Rb = Epi::PERM ? ((R & ~31) + perm32(R & 31)) : R;
        voffA[i] = (unsigned)(R * K + C) * 2u; voffB[i] = (unsigned)(Rb * K + C) * 2u; }
    const size_t kstep = (size_t)(BK * 2);
    const size_t hstep = (size_t)HALF * K * 2;
    const size_t tstep = 2 * hstep;
    const unsigned ldsw = (unsigned)wid * 1024u;
    const int aoff = lds_byte(wr * 64 + fr, fq * 8), boff = lds_byte(wc * 32 + fr, fq * 8);
#define PG8_SA(b, h) (((b) * 2 + (h)) * HTB)
#define PG8_SB(b, h) ((4 + (b) * 2 + (h)) * HTB)
#define PG8_STAGE(bufoff, gbase, voff) do { _Pragma("unroll") for (int _i = 0; _i < 2; ++_i) \
        __builtin_amdgcn_global_load_lds((const unsigned*)((const char*)(gbase) + (voff)[_i]), (PG8_LAS unsigned*)(lds + (bufoff) + ldsw + _i * 8192), 16, 0, 0); } while (0)
#define PG8_LDA(dst, b, h) do { _Pragma("unroll") for (int m = 0; m < 4; ++m) _Pragma("unroll") for (int k = 0; k < 2; ++k) dst[m][k] = *(const PG8_LAS bf16x8*)(lds + PG8_SA(b, h) + aoff + m * 2048 + k * 1024); } while (0)
#define PG8_LDB(dst, b, h) do { _Pragma("unroll") for (int n = 0; n < 2; ++n) _Pragma("unroll") for (int k = 0; k < 2; ++k) dst[n][k] = *(const PG8_LAS bf16x8*)(lds + PG8_SB(b, h) + boff + n * 2048 + k * 1024); } while (0)
#define PG8_MMA(ai, bj, At, Bt) do { __builtin_amdgcn_s_setprio(1); _Pragma("unroll") for (int m = 0; m < 4; ++m) _Pragma("unroll") for (int n = 0; n < 2; ++n) _Pragma("unroll") for (int k = 0; k < 2; ++k) \
        acc[ai][bj][m][n] = __builtin_amdgcn_mfma_f32_16x16x32_bf16(Bt[n][k], At[m][k], acc[ai][bj][m][n], 0, 0, 0); __builtin_amdgcn_s_setprio(0); } while (0)
#define PG8_WAIT_V(n) asm volatile("s_waitcnt vmcnt(" #n ")" ::: "memory")
#define PG8_WAIT_L(n) asm volatile("s_waitcnt lgkmcnt(" #n ")" ::: "memory")
#define PG8_BAR __builtin_amdgcn_s_barrier()
#define PG8_SCHED __builtin_amdgcn_sched_barrier(0)
    Unit cur, nxt; int ui = 0;
    if (!S.next(0, cur)) return;
    f32x4 acc[2][2][4][2];
#pragma unroll
    for (int a = 0; a < 2; ++a)
#pragma unroll
        for (int b = 0; b < 2; ++b)
#pragma unroll
            for (int m = 0; m < 4; ++m)
#pragma unroll
                for (int n = 0; n < 2; ++n) acc[a][b][m][n] = (f32x4){0.f, 0.f, 0.f, 0.f};
    bf16x8 At[4][2], B0[2][2], B1[2][2];
    const char* cA = (const char*)g.A + (size_t)cur.pm * tstep; const char* cB = (const char*)g.Bt + (size_t)cur.pn * tstep;
    S.a_ready(cur);
    if constexpr (SP2) {
        PG8_STAGE(PG8_SB(0, 0), cB, voffB); PG8_STAGE(PG8_SB(0, 1), cB + hstep, voffB); PG8_STAGE(PG8_SA(0, 0), cA, voffA); PG8_STAGE(PG8_SA(0, 1), cA + hstep, voffA);
        if (wr == 1) PG8_BAR;
        PG8_WAIT_V(2); PG8_BAR;
        PG8_STAGE(PG8_SB(1, 0), cB + kstep, voffB); PG8_STAGE(PG8_SA(1, 0), cA + kstep, voffA); PG8_STAGE(PG8_SB(1, 1), cB + hstep + kstep, voffB);
        PG8_WAIT_V(6); PG8_BAR;
    } else {
        PG8_STAGE(PG8_SB(0, 0), cB, voffB); PG8_STAGE(PG8_SA(0, 0), cA, voffA); PG8_STAGE(PG8_SB(0, 1), cB + hstep, voffB); PG8_STAGE(PG8_SA(0, 1), cA + hstep, voffA);
        if (wr == 1) PG8_BAR;
        PG8_WAIT_V(4); PG8_BAR;
        PG8_STAGE(PG8_SB(1, 0), cB + kstep, voffB); PG8_STAGE(PG8_SA(1, 0), cA + kstep, voffA); PG8_STAGE(PG8_SB(1, 1), cB + hstep + kstep, voffB);
        PG8_WAIT_V(6); PG8_BAR;
    }
    for (;;) {
        const bool has_next = S.next(ui + 1, nxt);
        const char* nA = has_next ? (const char*)g.A + (size_t)nxt.pm * tstep : cA; const char* nB = has_next ? (const char*)g.Bt + (size_t)nxt.pn * tstep : cB;
        for (int t = 0; t < nt; t += 2) {
            const bool last = (t == nt - 2);
            const char* a1 = cA + (size_t)(t + 1) * kstep;
            const char* a2 = last ? nA : cA + (size_t)(t + 2) * kstep; const char* b2 = last ? nB : cB + (size_t)(t + 2) * kstep;
            const char* a3 = a2 + kstep; const char* b3 = b2 + kstep;
            if (last && has_next) S.a_ready(nxt);
            if constexpr (SP2) {
            PG8_LDB(B0, 0, 0); PG8_LDB(B1, 0, 1); PG8_SCHED; PG8_LDA(At, 0, 0); PG8_STAGE(PG8_SA(1, 1), a1 + hstep, voffA);
            PG8_WAIT_V(8); PG8_WAIT_L(0); PG8_BAR; PG8_MMA(0, 0, At, B0); PG8_MMA(0, 1, At, B1); PG8_BAR; PG8_SCHED;
            PG8_LDA(At, 0, 1); PG8_STAGE(PG8_SB(0, 0), b2, voffB); PG8_STAGE(PG8_SB(0, 1), b2 + hstep, voffB); PG8_STAGE(PG8_SA(0, 0), a2, voffA);
            PG8_WAIT_V(8); PG8_WAIT_L(0); PG8_BAR; PG8_MMA(1, 0, At, B0); PG8_MMA(1, 1, At, B1); PG8_BAR; PG8_SCHED;
            PG8_LDB(B0, 1, 0); PG8_LDB(B1, 1, 1); PG8_SCHED; PG8_LDA(At, 1, 0); PG8_STAGE(PG8_SA(0, 1), a2 + hstep, voffA);
            PG8_WAIT_V(8); PG8_WAIT_L(0); PG8_BAR; PG8_MMA(0, 0, At, B0); PG8_MMA(0, 1, At, B1); PG8_BAR; PG8_SCHED;
            PG8_LDA(At, 1, 1); PG8_STAGE(PG8_SB(1, 0), b3, voffB); PG8_STAGE(PG8_SB(1, 1), b3 + hstep, voffB); PG8_STAGE(PG8_SA(1, 0), a3, voffA);
            PG8_WAIT_V(8); PG8_WAIT_L(0); PG8_BAR; PG8_MMA(1, 0, At, B0); PG8_MMA(1, 1, At, B1); PG8_BAR; PG8_SCHED;
            } else {
            PG8_LDB(B0, 0, 0); PG8_SCHED; PG8_LDA(At, 0, 0); PG8_STAGE(PG8_SA(1, 1), a1 + hstep, voffA);
            PG8_WAIT_L(8); PG8_BAR; PG8_WAIT_L(0); PG8_MMA(0, 0, At, B0); PG8_BAR; PG8_SCHED;
            PG8_LDB(B1, 0, 1); PG8_STAGE(PG8_SB(0, 0), b2, voffB);
            PG8_BAR; PG8_WAIT_L(0); PG8_MMA(0, 1, At, B1); PG8_BAR;
            PG8_LDA(At, 0, 1); PG8_STAGE(PG8_SA(0, 0), a2, voffA);
            PG8_BAR; PG8_WAIT_L(0); PG8_MMA(1, 0, At, B0); PG8_BAR; PG8_SCHED;
            PG8_STAGE(PG8_SB(0, 1), b2 + hstep, voffB);
            PG8_WAIT_V(6); PG8_BAR; PG8_MMA(1, 1, At, B1); PG8_BAR;
            PG8_LDB(B0, 1, 0); PG8_SCHED; PG8_LDA(At, 1, 0); PG8_STAGE(PG8_SA(0, 1), a2 + hstep, voffA);
            PG8_WAIT_L(8); PG8_BAR; PG8_WAIT_L(0); PG8_MMA(0, 0, At, B0); PG8_BAR; PG8_SCHED;
            PG8_LDB(B1, 1, 1); PG8_STAGE(PG8_SB(1, 0), b3, voffB);
            PG8_BAR; PG8_WAIT_L(0); PG8_MMA(0, 1, At, B1); PG8_BAR;
            PG8_LDA(At, 1, 1); PG8_STAGE(PG8_SA(1, 0), a3, voffA);
            PG8_BAR; PG8_WAIT_L(0); PG8_MMA(1, 0, At, B0); PG8_BAR; PG8_SCHED;
            PG8_STAGE(PG8_SB(1, 1), b3 + hstep, voffB);
            PG8_WAIT_V(6); PG8_BAR; PG8_MMA(1, 1, At, B1); PG8_BAR;
            }
        }
        if constexpr (ALIGN_EPI) { if (wr == 0) PG8_BAR; }
        if constexpr (!Epi::AFTER_DRAIN) { E(acc, cur, wr, wc, fr, fq); S.done(cur); }
        if (!has_next) break;
#pragma unroll
        for (int a = 0; a < 2; ++a)
#pragma unroll
            for (int b = 0; b < 2; ++b)
#pragma unroll
                for (int m = 0; m < 4; ++m)
#pragma unroll
                    for (int n = 0; n < 2; ++n) acc[a][b][m][n] = (f32x4){0.f, 0.f, 0.f, 0.f};
        cur = nxt; cA = nA; cB = nB; ++ui;
        if constexpr (ALIGN_EPI) { if (wr == 1) PG8_BAR; }
    }
    PG8_WAIT_V(0);
    if constexpr (!ALIGN_EPI) { if (wr == 0) PG8_BAR; }
    PG8_BAR;
    if constexpr (Epi::AFTER_DRAIN) { E.fused(acc, cur, wr, wc, fr, fq, lds, wid, lane); S.done(cur); }
#undef PG8_SA
#undef PG8_SB
#undef PG8_STAGE
#undef PG8_LDA
#undef PG8_LDB
#undef PG8_MMA
#undef PG8_WAIT_V
#undef PG8_WAIT_L
#undef PG8_BAR
#undef PG8_SCHED
}
}

constexpr int MTOK = 16 * 2048, SEQ = 2048, DM = 1024, DIN = 2560, WP = 512, WC = 512;
constexpr int MISC_OFF = 131072, LDS_BYTES = 131072 + 256, NTHR = 512;
constexpr size_t WS_WIN = 0, WS_PW = WS_WIN + (size_t)DIN * DM * 2, WS_WOUT = WS_PW + (size_t)WC * WC * 2, WS_HN = WS_WOUT + (size_t)DM * DM * 2,
                 WS_P = WS_HN + (size_t)MTOK * DM * 2, WS_HC = WS_P + (size_t)MTOK * 2048 * 2, WS_Y = WS_HC + (size_t)MTOK * WC * 2, WS_PART = WS_Y + (size_t)MTOK * DM * 2,
                 WS_BAR = WS_PART + (size_t)MTOK * 16 * 4, WS_DELTA = WS_HN  , WS_END = WS_BAR + 16384;
#define LAS __attribute__((address_space(3)))
typedef unsigned short bf16;
typedef float f32x4 __attribute__((ext_vector_type(4)));
typedef float f32x2 __attribute__((ext_vector_type(2)));
typedef unsigned u32x4 __attribute__((ext_vector_type(4)));
typedef unsigned u32x2 __attribute__((ext_vector_type(2)));
#define LDS_WAIT() asm volatile("s_waitcnt lgkmcnt(0)" ::: "memory")
using pg8::cvt_pk_bf16; using pg8::silu; using pg8::bf_lo; using pg8::bf_hi;

#define RLX_AGENT __ATOMIC_RELAXED, __HIP_MEMORY_SCOPE_AGENT
#define XB_TMO      128
#define XB_XCNT(j)  (256  + 64 * (j))
#define XB_XSUB(j)  (1280 + 64 * (j))
#define XB_XGEN(j)  (2304 + 64 * (j))
#define XB_TOP      3328
#define XB_TOPGEN   3392
#define XCD_BAR_WORDS 3456
#define XB_SPIN_CAP (1u << 18)

__device__ __forceinline__ unsigned xb_ld(unsigned* p)              { return __hip_atomic_load(p, __ATOMIC_RELAXED, __HIP_MEMORY_SCOPE_AGENT); }
__device__ __forceinline__ unsigned xb_add(unsigned* p, unsigned v) { return __hip_atomic_fetch_add(p, v, __ATOMIC_RELAXED, __HIP_MEMORY_SCOPE_AGENT); }
__device__ __forceinline__ unsigned xb_xcc_id() { return (unsigned)__builtin_amdgcn_s_getreg((3 << 11) | 20) & 0xFu; }
#define XB_SPIN(cond, bar) do { unsigned _sp = 0; while (cond) { __builtin_amdgcn_s_sleep(1); \
    if ((++_sp & 255u) == 0u) { if (xb_ld(&(bar)[XB_TMO])) break; if (_sp > XB_SPIN_CAP) { atomicAdd(&(bar)[XB_TMO], 1u); break; } } } } while (0)

struct XcdBarrier {
    unsigned* bar; unsigned x;
    volatile LAS unsigned* st;
};

__device__ __forceinline__ XcdBarrier xcd_barrier_post(unsigned* bar, volatile LAS unsigned* st) {
    XcdBarrier b; b.bar = bar; b.x = xb_xcc_id(); b.st = st;
    if (threadIdx.x == 0) (void)xb_add(&bar[XB_XCNT(b.x)], 1u);
    return b;
}
__device__ __forceinline__ void xcd_barrier_complete(unsigned* bar, unsigned x, unsigned& nloc, unsigned& nx) {
    const unsigned G = gridDim.x * gridDim.y * gridDim.z;
    unsigned sum, cnt, mine, sp = 0u;
    for (;;) {
        sum = 0u; cnt = 0u; mine = 0u;
#pragma unroll
        for (unsigned j = 0; j < 16; ++j) { const unsigned c = xb_ld(&bar[XB_XCNT(j)]); sum += c; cnt += (c > 0u) ? 1u : 0u; mine = (j == x) ? c : mine; }
        if (sum == G) break;
        __builtin_amdgcn_s_sleep(1);
        if ((++sp & 255u) == 0u) { if (xb_ld(&bar[XB_TMO])) break; if (sp > XB_SPIN_CAP) { atomicAdd(&bar[XB_TMO], 1u); break; } }
    }
    nloc = mine > 0u ? mine : 1u; nx = cnt > 0u ? cnt : 1u;
}

__device__ __forceinline__ void xcd_barrier(const XcdBarrier& b) {
    asm volatile("s_waitcnt vmcnt(0)" ::: "memory");
    __syncthreads();
    if (threadIdx.x == 0) {
        unsigned* bar = b.bar;
        __builtin_amdgcn_s_waitcnt(0);
        unsigned nloc = b.st[0], nx = b.st[1];
        if (nloc == 0u) { xcd_barrier_complete(bar, b.x, nloc, nx); b.st[0] = nloc; b.st[1] = nx; }
        const unsigned old = xb_add(&bar[XB_XSUB(b.x)], 1u);
        const unsigned gen = old / nloc;
        if (old + 1u == (gen + 1u) * nloc) {
            __builtin_amdgcn_fence(__ATOMIC_RELEASE, "agent");
            asm volatile("s_waitcnt vmcnt(0)" ::: "memory");
            const unsigned og = xb_add(&bar[XB_TOP], 1u);
            const unsigned tg = og / nx;
            if (og + 1u == (tg + 1u) * nx) xb_add(&bar[XB_TOPGEN], 1u);
            else XB_SPIN(xb_ld(&bar[XB_TOPGEN]) == tg, bar);
            __builtin_amdgcn_fence(__ATOMIC_ACQUIRE, "agent");
            xb_add(&bar[XB_XGEN(b.x)], 1u);
            asm volatile("s_waitcnt vmcnt(0)" ::: "memory");
        } else {
            XB_SPIN(xb_ld(&bar[XB_XGEN(b.x)]) == gen, bar);
            __builtin_amdgcn_fence(__ATOMIC_ACQUIRE, "agent");
            asm volatile("s_waitcnt vmcnt(0)" ::: "memory");
        }
    }
    __syncthreads();
}

struct Params {
    const float *x, *norm_g, *w_in, *pool_w, *pool_b, *pool_scale, *conv_dw, *conv_b, *ln_g, *ln_b, *pw_w, *pw_b, *w_out, *final_g;
    float* out; unsigned char* ws;
};

__device__ __forceinline__ float wave_sum(float v) {
#pragma unroll
    for (int o = 1; o < 64; o <<= 1) v += __shfl_xor(v, o);
    return v;
}
__device__ __forceinline__ float wave_sum_dpp(float v) {
#define DPP_ADD(ctrl) v += __builtin_bit_cast(float, __builtin_amdgcn_update_dpp(0, __builtin_bit_cast(int, v), (ctrl), 0xf, 0xf, true))
    DPP_ADD(0xB1);
    DPP_ADD(0x4E);
    DPP_ADD(0x141);
    DPP_ADD(0x140);
#undef DPP_ADD
    const int b = __builtin_bit_cast(int, v);
    return (__builtin_bit_cast(float, __builtin_amdgcn_readlane(b, 0)) + __builtin_bit_cast(float, __builtin_amdgcn_readlane(b, 16))) + (__builtin_bit_cast(float, __builtin_amdgcn_readlane(b, 32)) + __builtin_bit_cast(float, __builtin_amdgcn_readlane(b, 48)));
}
__device__ __forceinline__ void wave_sum_dpp4(float (&v)[4]) {
#define DPP_ADD4(ctrl) _Pragma("unroll") for (int i = 0; i < 4; ++i) v[i] += __builtin_bit_cast(float, __builtin_amdgcn_update_dpp(0, __builtin_bit_cast(int, v[i]), (ctrl), 0xf, 0xf, true))
    DPP_ADD4(0xB1); DPP_ADD4(0x4E); DPP_ADD4(0x141); DPP_ADD4(0x140);
#undef DPP_ADD4
#pragma unroll
    for (int i = 0; i < 4; ++i) { const int b = __builtin_bit_cast(int, v[i]);
        v[i] = (__builtin_bit_cast(float, __builtin_amdgcn_readlane(b, 0)) + __builtin_bit_cast(float, __builtin_amdgcn_readlane(b, 16))) + (__builtin_bit_cast(float, __builtin_amdgcn_readlane(b, 32)) + __builtin_bit_cast(float, __builtin_amdgcn_readlane(b, 48))); }
}
__device__ __forceinline__ void transpose_item(const float* W, int ldw, int scol0, int k0, bf16* WT, int ldt, int drow0, LAS float* scr, int lane) {
    float tv[32];
#pragma unroll
    for (int i = 0; i < 32; ++i) tv[i] = W[(size_t)(k0 + 2 * i + (lane >> 5)) * ldw + scol0 + (lane & 31)];
#pragma unroll
    for (int i = 0; i < 32; ++i) scr[(2 * i + (lane >> 5)) * 33 + (lane & 31)] = tv[i];
    LDS_WAIT();
    const int c = lane & 7;
#pragma unroll
    for (int j = 0; j < 4; ++j) { const int n = (lane >> 3) + 8 * j; const LAS float* s = scr + (8 * c) * 33 + n;
        u32x4 o; o.x = cvt_pk_bf16(s[0 * 33], s[1 * 33]); o.y = cvt_pk_bf16(s[2 * 33], s[3 * 33]); o.z = cvt_pk_bf16(s[4 * 33], s[5 * 33]); o.w = cvt_pk_bf16(s[6 * 33], s[7 * 33]);
        *(u32x4*)(WT + (size_t)(drow0 + n) * ldt + k0 + 8 * c) = o; }
    LDS_WAIT();
}
__device__ __forceinline__ void poolfold_wg(const float* w_in, const float* pool_w, bf16* WinT, int g, int k0, LAS unsigned char* lds, int tid, int wave, int lane) {
    LAS float* pw = (LAS float*)lds;
    LAS float* wi = (LAS float*)(lds + 65536);
    const f32x4* src = (const f32x4*)(pool_w + (size_t)g * 128 * 128) + tid; f32x4 t[8];
#pragma unroll
    for (int i = 0; i < 8; ++i) t[i] = src[i * NTHR];
    const f32x4 wv = *(const f32x4*)(w_in + (size_t)(k0 + (tid >> 5)) * DIN + 128 * g + 4 * (tid & 31));
#pragma unroll
    for (int i = 0; i < 8; ++i) *((LAS f32x4*)pw + tid + i * NTHR) = t[i];
    *((LAS f32x4*)wi + tid) = wv;
    __syncthreads();
    float a00 = 0.f, a01 = 0.f, a10 = 0.f, a11 = 0.f;
    const LAS float* w0 = wi + (2 * wave) * 128; const LAS float* w1 = w0 + 128;
#pragma unroll 4
    for (int c4 = 0; c4 < 32; ++c4) { const f32x4 x0 = *(const LAS f32x4*)(w0 + 4 * c4), x1 = *(const LAS f32x4*)(w1 + 4 * c4);
#pragma unroll
        for (int cc = 0; cc < 4; ++cc) { const float p0 = pw[(4 * c4 + cc) * 128 + lane], p1 = pw[(4 * c4 + cc) * 128 + 64 + lane];
            a00 += x0[cc] * p0; a01 += x0[cc] * p1; a10 += x1[cc] * p0; a11 += x1[cc] * p1; } }
    *(unsigned*)(WinT + (size_t)(128 * g + lane) * DM + k0 + 2 * wave) = cvt_pk_bf16(a00, a10);
    *(unsigned*)(WinT + (size_t)(128 * g + 64 + lane) * DM + k0 + 2 * wave) = cvt_pk_bf16(a01, a11);
    __syncthreads();
}

__device__ __forceinline__ void phase_prep(const Params& p, LAS unsigned char* lds, int bid, int G) {
    int tid_ = threadIdx.x; asm volatile("" : "+v"(tid_)); const int tid = tid_, lane = tid & 63, wave = __builtin_amdgcn_readfirstlane(tid >> 6);
    LAS float* scr = (LAS float*)(lds + wave * 8704);
    bf16* WinT = (bf16*)(p.ws + WS_WIN); bf16* PwT = (bf16*)(p.ws + WS_PW); bf16* WoutT = (bf16*)(p.ws + WS_WOUT); bf16* HN = (bf16*)(p.ws + WS_HN);
    const int gw = bid * 8 + wave, NGW = G * 8;
    for (int t = bid; t < 256; t += G) poolfold_wg(p.w_in, p.pool_w, WinT, t & 3, 16 * (t >> 2), lds, tid, wave, lane);
    if (wave < 2) for (int t = bid + G * wave; t < 1664; t += 2 * G) {
        if (t < 1024) { const int kb = t >> 6, nb = t & 63, n = 512 + 32 * nb; int scol;
            if (n < 1024 || n >= 2048) scol = n; else { const int q = (n - 1024) >> 8, r = (n - 1024) & 255; scol = r < 128 ? 1024 + 128 * q + r : 1536 + 128 * q + (r - 128); }
            transpose_item(p.w_in, DIN, scol, 64 * kb, WinT, DM, n, scr, lane); }
        else if (t < 1152) { const int it = t - 1024, kb = it >> 4, nb = it & 15; transpose_item(p.pw_w, WC, 32 * nb, 64 * kb, PwT, WC, 32 * nb, scr, lane); }
        else { const int it = t - 1152, kb = it >> 5, nb = it & 31; transpose_item(p.w_out, DM, 32 * nb, 64 * kb, WoutT, DM, 32 * nb, scr, lane); }
    }
    f32x4 gv[4];
#pragma unroll
    for (int j = 0; j < 4; ++j) gv[j] = *((const f32x4*)p.norm_g + lane + 64 * j);
    LAS int* ticket = (LAS int*)(lds + MISC_OFF + 64);
    for (;;) {
        int c = 0; if (lane == 0) c = __hip_atomic_fetch_add(ticket, 1, __ATOMIC_RELAXED, __HIP_MEMORY_SCOPE_WORKGROUP);
        c = __builtin_amdgcn_readfirstlane(c);
        const int m0 = 4 * (bid + G * c); if (m0 >= MTOK) break;
        const f32x4* xr = (const f32x4*)(p.x + (size_t)m0 * DM) + lane; f32x4 v[4][4];
#pragma unroll
        for (int r = 0; r < 4; ++r)
#pragma unroll
            for (int j = 0; j < 4; ++j) v[r][j] = xr[r * 256 + 64 * j];
        __builtin_amdgcn_sched_barrier(0);
#pragma unroll
        for (int r = 0; r < 4; ++r) { float s = 0.f;
#pragma unroll
            for (int j = 0; j < 4; ++j) s += (v[r][j].x * v[r][j].x + v[r][j].y * v[r][j].y) + (v[r][j].z * v[r][j].z + v[r][j].w * v[r][j].w);
            const float rs = 1.0f / sqrtf(wave_sum_dpp(s) * (1.0f / DM) + 1e-6f);
            u32x2* o8 = (u32x2*)(HN + (size_t)(m0 + r) * DM) + lane;
#pragma unroll
            for (int j = 0; j < 4; ++j) { const f32x4 y = v[r][j] * rs * gv[j]; u32x2 w; w.x = cvt_pk_bf16(y.x, y.y); w.y = cvt_pk_bf16(y.z, y.w); o8[64 * j] = w; } }
    }
}

__device__ __forceinline__ void mixer_load_h(const bf16* P, int tile, int wave, int lane, u32x4 (&hv)[8]) {
    const int t0 = tile * 32, s0 = t0 & (SEQ - 1);
#pragma unroll
    for (int k = 0; k < 8; ++k) { const int r = wave + 8 * k; const bool ok = (s0 - 30 + r >= 0) && (r < 62);
        const u32x4 v = *(const u32x4*)(P + 2 * pg8::PSEC + (size_t)(ok ? t0 - 30 + r : t0) * 512 + lane * 8);
        hv[k] = ok ? v : (u32x4){0u, 0u, 0u, 0u}; }
}
#define GAS __attribute__((address_space(1)))
#define FMAC(acc, x_, y_) asm("v_fmac_f32 %0, %1, %2" : "+v"(acc) : "v"(x_), "v"(y_))
template <int W> __device__ __forceinline__ void pool_compute(const unsigned (&ur)[31], const unsigned (&ag)[16], int sa, f32x2 pb, f32x2 ps, bf16* yp) {
    float s0 = 0.f, s1 = 0.f;
#pragma unroll
    for (int i = 16 - W; i <= 15; ++i) { s0 += bf_lo(ur[i]); s1 += bf_hi(ur[i]); }
#pragma unroll
    for (int r = 0; r < 16; ++r) {
        if (r > 0) { s0 += bf_lo(ur[15 + r]) - bf_lo(ur[15 + r - W]); s1 += bf_hi(ur[15 + r]) - bf_hi(ur[15 + r - W]); }
        const int cnt = sa + r + 1 < W ? sa + r + 1 : W; const float inv = __builtin_amdgcn_rcpf((float)cnt);
        const float z0 = s0 * inv - bf_lo(ur[15 + r]) + pb.x, z1 = s1 * inv - bf_hi(ur[15 + r]) + pb.y;
        *(unsigned*)(yp + (size_t)r * DM) = cvt_pk_bf16(z0 * ps.x * bf_lo(ag[r]), z1 * ps.y * bf_hi(ag[r]));
    }
}
__device__ __forceinline__ void phase_mixer(const Params& p, LAS unsigned char* lds, int bid, int G) {
    int tid_ = threadIdx.x; asm volatile("" : "+v"(tid_)); const int tid = tid_, lane = tid & 63, wave = __builtin_amdgcn_readfirstlane(tid >> 6);
    const bf16* P = (const bf16*)(p.ws + WS_P); bf16* HC = (bf16*)(p.ws + WS_HC); bf16* Y = (bf16*)(p.ws + WS_Y);
    LAS unsigned char* Hs = lds;
    LAS float* Cs = (LAS float*)(lds + 62 * 1024);
    const int cp = tid & 255, th = tid >> 8;
    const int pgp = wave & 3, pth = wave >> 2, pw_ = 2 << pgp, pc0 = 128 * pgp + 2 * lane;
    const f32x2 pb = *(const f32x2*)(p.pool_b + pc0), ps = *(const f32x2*)(p.pool_scale + pc0);
    const f32x4 lg0 = *(const f32x4*)(p.ln_g + 4 * lane), lg1 = *(const f32x4*)(p.ln_g + 256 + 4 * lane), lb0 = *(const f32x4*)(p.ln_b + 4 * lane), lb1 = *(const f32x4*)(p.ln_b + 256 + 4 * lane);
    const f32x2 cb = *(const f32x2*)(p.conv_b + 2 * cp);
    const int NT = MTOK / 32;
    f32x2 tw[31];
#pragma unroll
    for (int j = 0; j < 31; ++j) tw[j] = *(const f32x2*)(p.conv_dw + j * WC + 2 * cp);
    u32x4 hv[8];
    const bool xo = (G == 256); const int tbase = xo ? 128 * (bid & 7) + (bid >> 3) : bid, tstep_ = xo ? 32 : G, ntrip = xo ? 4 : (NT - bid + G - 1) / G;
    if (ntrip > 0) mixer_load_h(P, tbase, wave, lane, hv);
    for (int it = 0; it < ntrip; ++it) { const int tile = tbase + it * tstep_;
        const int t0 = tile * 32, s0 = t0 & (SEQ - 1);
        const int ta = t0 + 16 * pth, sa = s0 + 16 * pth;
#pragma unroll
        for (int k = 0; k < 8; ++k) { const int r = wave + 8 * k; if (r < 62) *(LAS u32x4*)(Hs + r * 1024 + lane * 16) = hv[k]; }
        unsigned ur[31], ag[16];
#pragma unroll
        for (int i = 0; i < 31; ++i) { const bool ok = (i >= 16 - pw_) && (sa - 15 + i >= 0);
            const unsigned v = *(const unsigned*)(P + (size_t)(ok ? ta - 15 + i : ta) * 512 + pc0); ur[i] = ok ? v : 0u; }
#pragma unroll
        for (int r = 0; r < 16; ++r) ag[r] = *(const unsigned*)(P + pg8::PSEC + (size_t)(ta + r) * 512 + pc0);
        if (it + 1 < ntrip) mixer_load_h(P, tile + tstep_, wave, lane, hv);
        __builtin_amdgcn_sched_barrier(0);
        __syncthreads();
        {
            float a0[16], a1[16];
#pragma unroll
            for (int r = 0; r < 16; ++r) { a0[r] = cb.x; a1[r] = cb.y; }
            const LAS unsigned* hp = (const LAS unsigned*)(Hs + (th * 16) * 1024 + cp * 4);
#pragma unroll
            for (int i = 0; i < 46; ++i) { const unsigned w = hp[i * 256]; const float v0 = bf_lo(w), v1 = bf_hi(w);
#pragma unroll
                for (int r = 0; r < 16; ++r) { const int j = i - r; if (j >= 0 && j <= 30) { FMAC(a0[r], tw[j].x, v0); FMAC(a1[r], tw[j].y, v1); } } }
#pragma unroll
            for (int r = 0; r < 16; ++r) *(LAS f32x2*)(Cs + (th * 16 + r) * 512 + 2 * cp) = (f32x2){a0[r], a1[r]};
        }
        __builtin_amdgcn_sched_barrier(0);
        __syncthreads();
        {
            f32x4 v0[4], v1[4]; float sa4[4];
#pragma unroll
            for (int rr = 0; rr < 4; ++rr) { const int row = 4 * wave + rr;
                v0[rr] = *(const LAS f32x4*)(Cs + row * 512 + 4 * lane); v1[rr] = *(const LAS f32x4*)(Cs + row * 512 + 256 + 4 * lane);
                sa4[rr] = ((v0[rr].x + v0[rr].y) + (v0[rr].z + v0[rr].w)) + ((v1[rr].x + v1[rr].y) + (v1[rr].z + v1[rr].w)); }
            wave_sum_dpp4(sa4);
#pragma unroll
            for (int rr = 0; rr < 4; ++rr) { const float mean = sa4[rr] * (1.0f / 512.0f); v0[rr] = v0[rr] - mean; v1[rr] = v1[rr] - mean;
                sa4[rr] = ((v0[rr].x * v0[rr].x + v0[rr].y * v0[rr].y) + (v0[rr].z * v0[rr].z + v0[rr].w * v0[rr].w)) + ((v1[rr].x * v1[rr].x + v1[rr].y * v1[rr].y) + (v1[rr].z * v1[rr].z + v1[rr].w * v1[rr].w)); }
            wave_sum_dpp4(sa4);
#pragma unroll
            for (int rr = 0; rr < 4; ++rr) { const int row = 4 * wave + rr; const float rstd = __builtin_amdgcn_rsqf(sa4[rr] * (1.0f / 512.0f) + 1e-5f);
                const f32x4 y0 = v0[rr] * rstd * lg0 + lb0, y1 = v1[rr] * rstd * lg1 + lb1;
                u32x2 w0, w1; w0.x = cvt_pk_bf16(silu(y0.x), silu(y0.y)); w0.y = cvt_pk_bf16(silu(y0.z), silu(y0.w)); w1.x = cvt_pk_bf16(silu(y1.x), silu(y1.y)); w1.y = cvt_pk_bf16(silu(y1.z), silu(y1.w));
                bf16* o = HC + (size_t)(t0 + row) * WC; *(u32x2*)(o + 4 * lane) = w0; *(u32x2*)(o + 256 + 4 * lane) = w1; }
        }
        __builtin_amdgcn_sched_barrier(0);
        { bf16* yp = Y + (size_t)ta * DM + pc0;
          if (pgp == 0) pool_compute<2>(ur, ag, sa, pb, ps, yp); else if (pgp == 1) pool_compute<4>(ur, ag, sa, pb, ps, yp);
          else if (pgp == 2) pool_compute<8>(ur, ag, sa, pb, ps, yp); else pool_compute<16>(ur, ag, sa, pb, ps, yp); }
    }
    __syncthreads();
}

__device__ __forceinline__ void phase_final(const Params& p, int bid, int G) {
    int tid_ = threadIdx.x; asm volatile("" : "+v"(tid_)); const int tid = tid_, lane = tid & 63, wave = __builtin_amdgcn_readfirstlane(tid >> 6);
    const bf16* DL = (const bf16*)(p.ws + WS_DELTA);
    const int gw = bid * 8 + wave, NGW = G * 8;
    f32x4 gv[4];
#pragma unroll
    for (int j = 0; j < 4; ++j) gv[j] = *((const f32x4*)p.final_g + lane + 64 * j);
    for (int m0 = gw * 4; m0 < MTOK; m0 += NGW * 4) {
        const f32x4* xr = (const f32x4*)(p.x + (size_t)m0 * DM) + lane; const u32x2* dr = (const u32x2*)(DL + (size_t)m0 * DM) + lane;
        f32x4 v[4][4]; u32x2 d[4][4];
#pragma unroll
        for (int r = 0; r < 4; ++r)
#pragma unroll
            for (int j = 0; j < 4; ++j) { v[r][j] = xr[r * 256 + 64 * j]; d[r][j] = dr[r * 256 + 64 * j]; }
        __builtin_amdgcn_sched_barrier(0);
#pragma unroll
        for (int r = 0; r < 4; ++r) { float s = 0.f;
#pragma unroll
            for (int j = 0; j < 4; ++j) { v[r][j].x += bf_lo(d[r][j].x); v[r][j].y += bf_hi(d[r][j].x); v[r][j].z += bf_lo(d[r][j].y); v[r][j].w += bf_hi(d[r][j].y);
                s += (v[r][j].x * v[r][j].x + v[r][j].y * v[r][j].y) + (v[r][j].z * v[r][j].z + v[r][j].w * v[r][j].w); }
            const float rs = 1.0f / sqrtf(wave_sum_dpp(s) * (1.0f / DM) + 1e-6f);
            f32x4* o = (f32x4*)(p.out + (size_t)(m0 + r) * DM) + lane;
#pragma unroll
            for (int j = 0; j < 4; ++j) o[64 * j] = v[r][j] * rs * gv[j]; }
    }
}

__global__ void __launch_bounds__(NTHR, 2) fwd_mega(Params p) {
    extern __shared__ __attribute__((aligned(16))) unsigned char lds_raw[];
    LAS unsigned char* lds = (LAS unsigned char*)lds_raw;
    const int bid = blockIdx.x, G = gridDim.x;
    const bf16* WinT = (const bf16*)(p.ws + WS_WIN); const bf16* PwT = (const bf16*)(p.ws + WS_PW); const bf16* WoutT = (const bf16*)(p.ws + WS_WOUT);
    const bf16* HN = (const bf16*)(p.ws + WS_HN); bf16* P = (bf16*)(p.ws + WS_P); const bf16* HC = (const bf16*)(p.ws + WS_HC); bf16* Y = (bf16*)(p.ws + WS_Y);
    bf16* DL = (bf16*)(p.ws + WS_DELTA);

    volatile LAS unsigned* MISC = (volatile LAS unsigned*)(lds + MISC_OFF);
    if (threadIdx.x < 64) MISC[threadIdx.x] = 0u;
    __syncthreads();
    XcdBarrier bar = xcd_barrier_post((unsigned*)(p.ws + WS_BAR), MISC + 8);
#define GSYNC() xcd_barrier(bar)
    phase_prep(p, lds, bid, G);
    GSYNC();
    {
        pg8::Gemm g{HN, WinT, MTOK, DIN, DM}; pg8::StaticOrder S; S.init(MTOK, DIN, G, bid);
        pg8::EpiProj E{P};
        pg8::gemm_phase<pg8::EpiProj, pg8::StaticOrder, true, true>(lds, g, S, E);
    }
    GSYNC();
    phase_mixer(p, lds, bid, G);
    GSYNC();
    {
        pg8::Gemm g{HC, PwT, MTOK, WC, WC}; pg8::StaticOrder S; S.init(MTOK, WC, G, bid);
        pg8::EpiPw E{P, Y, p.pw_b};
        pg8::gemm_phase<pg8::EpiPw, pg8::StaticOrder, true, true>(lds, g, S, E);
    }
    GSYNC();
    {
        pg8::Gemm g{Y, WoutT, MTOK, DM, DM}; pg8::StaticOrder S; S.init(MTOK, DM, G, bid);
        pg8::EpiDelta E{DL};
        pg8::gemm_phase<pg8::EpiDelta, pg8::StaticOrder, true, true>(lds, g, S, E);
    }
    GSYNC();
    phase_final(p, bid, G);
}

extern "C" void kernel_launch(void* const* d_in, const int* in_sizes, int n_in, void* d_out, int out_size, void* d_ws, size_t ws_size, hipStream_t stream) {
    static int grid_blocks = 0;
    if (grid_blocks == 0) {
        if (n_in != 14 || in_sizes[0] != MTOK * DM || out_size != MTOK * DM || ws_size < WS_END) { fprintf(stderr, "kernel_launch: unexpected shapes (n_in %d, ws %zu)\n", n_in, ws_size); grid_blocks = -1; return; }
        int dev = 0, cus = 0, per_cu = 0;
        (void)hipGetDevice(&dev); (void)hipDeviceGetAttribute(&cus, hipDeviceAttributeMultiprocessorCount, dev);
        if (hipFuncSetAttribute((const void*)fwd_mega, hipFuncAttributeMaxDynamicSharedMemorySize, LDS_BYTES) != hipSuccess) { fprintf(stderr, "kernel_launch: hipFuncSetAttribute failed\n"); grid_blocks = -1; return; }
        if (hipOccupancyMaxActiveBlocksPerMultiprocessor(&per_cu, (const void*)fwd_mega, NTHR, LDS_BYTES) != hipSuccess || per_cu < 1) { fprintf(stderr, "kernel_launch: occupancy query failed (%d)\n", per_cu); (void)hipGetLastError(); per_cu = 1; }
        if (per_cu > 1) per_cu = 1;
        grid_blocks = cus * per_cu;
    }
    if (grid_blocks < 0) return;
    Params p{};
    p.x = (const float*)d_in[0]; p.norm_g = (const float*)d_in[1]; p.w_in = (const float*)d_in[2]; p.pool_w = (const float*)d_in[3]; p.pool_b = (const float*)d_in[4];
    p.pool_scale = (const float*)d_in[5]; p.conv_dw = (const float*)d_in[6]; p.conv_b = (const float*)d_in[7]; p.ln_g = (const float*)d_in[8]; p.ln_b = (const float*)d_in[9];
    p.pw_w = (const float*)d_in[10]; p.pw_b = (const float*)d_in[11]; p.w_out = (const float*)d_in[12]; p.final_g = (const float*)d_in[13];
    p.out = (float*)d_out; p.ws = (unsigned char*)d_ws;
    if (hipMemsetAsync((char*)d_ws + WS_BAR, 0, 16384, stream) != hipSuccess) { fprintf(stderr, "kernel_launch: memset failed\n"); return; }
    hipLaunchKernelGGL(fwd_mega, dim3(grid_blocks), dim3(NTHR), LDS_BYTES, stream, p);
    const hipError_t e = hipPeekAtLastError();
    if (e != hipSuccess) fprintf(stderr, "kernel_launch: launch failed: %s (grid %d)\n", hipGetErrorString(e), grid_blocks);
}
```

```cpp
#include <hip/hip_runtime.h>
#include <cstdio>
#include <cstdint>
namespace pg8 {
#define PG8_LAS __attribute__((address_space(3)))
typedef unsigned short bf16_t;
typedef short bf16x8 __attribute__((ext_vector_type(8)));
typedef float f32x4 __attribute__((ext_vector_type(4)));
typedef unsigned u32x4 __attribute__((ext_vector_type(4)));
constexpr int BM = 256, BK = 64, HALF = 128, HTB = HALF * BK * 2  , STAGE_BYTES = 8 * HTB, NXCD = 8, WGM = 8;

__host__ __device__ __forceinline__ int lds_byte(int r, int c) { const int st = (r >> 4) * 2 + (c >> 5), rr = r & 15, cc = c & 31, ob = rr * 64 + cc * 2; return st * 1024 + (ob ^ (((ob >> 9) & 1) << 5)); }
__host__ __device__ __forceinline__ void stage_rc(int b, int& R, int& C) { const int st = b / 1024, sb = b % 1024, swz = sb ^ (((sb >> 9) & 1) << 5); R = (st >> 1) * 16 + swz / 64; C = (st & 1) * 32 + (swz % 64) / 2; }
__host__ __device__ __forceinline__ int perm32(int rho) { const int n = rho >> 4, i = rho & 15; return 8 * (i >> 2) + 4 * n + (i & 3); }

struct Unit { int pm, pn; };
struct Gemm { const bf16_t* A; const bf16_t* Bt; int M, N, K; };

struct StaticOrder {
    int nM, nN, nwg, G, c;
    __host__ __device__ void init(int M, int N, int G_, int c_) { nM = M / BM; nN = N / BM; nwg = nM * nN; G = G_; c = c_; }
    __host__ __device__ bool next(int i, Unit& u) const {
        const long L = (long)i * G + c; if (L >= nwg) return false;
        int wgid = (int)L; { const int q = nwg / NXCD, r = nwg % NXCD, xcd = wgid % NXCD, off = wgid / NXCD; wgid = (xcd < r ? xcd * (q + 1) : r * (q + 1) + (xcd - r) * q) + off; }
        const int nig = WGM * nN, gid = wgid / nig, fm = gid * WGM, gsz = (nM - fm) < WGM ? (nM - fm) : WGM;
        u.pm = fm + ((wgid % nig) % gsz); u.pn = (wgid % nig) / gsz; return true;
    }
    __device__ __forceinline__ void a_ready(const Unit&) const {}
    __device__ __forceinline__ void done(const Unit&) const {}
};
__device__ __forceinline__ unsigned cvt_pk_bf16(float lo, float hi) { unsigned r; asm volatile("v_cvt_pk_bf16_f32 %0, %1, %2" : "=v"(r) : "v"(lo), "v"(hi)); return r; }
typedef float f32x2 __attribute__((ext_vector_type(2)));

__device__ __forceinline__ float sigm(float v) { return __builtin_amdgcn_rcpf(1.0f + __expf(-v)); }
__device__ __forceinline__ float silu(float v) { return v * sigm(v); }
constexpr size_t PSEC = (size_t)16 * 2048 * 512;
struct EpiProj {
    static constexpr bool PERM = true, AFTER_DRAIN = false;
    bf16_t* P;
    __device__ __forceinline__ void operator()(const f32x4 (&acc)[2][2][4][2], const Unit& u, int wr, int wc, int fr, int fq) const {
        const int row0 = u.pm * BM + wr * 64 + fr; const int pn = u.pn;
        if (pn >= 4 && pn < 8) {
            const int col0 = 128 * (pn - 4) + wc * 32 + 8 * fq; bf16_t* Ps = P + (size_t)2 * PSEC;
#pragma unroll
            for (int ai = 0; ai < 2; ++ai)
#pragma unroll
                for (int m = 0; m < 4; ++m) { bf16_t* rowp = Ps + (size_t)(row0 + ai * HALF + m * 16) * 512 + col0;
                    const f32x4 v0 = acc[ai][0][m][0], v1 = acc[ai][0][m][1], g0 = acc[ai][1][m][0], g1 = acc[ai][1][m][1];
                    u32x4 w; w.x = cvt_pk_bf16(v0[0] * sigm(g0[0]), v0[1] * sigm(g0[1])); w.y = cvt_pk_bf16(v0[2] * sigm(g0[2]), v0[3] * sigm(g0[3]));
                    w.z = cvt_pk_bf16(v1[0] * sigm(g1[0]), v1[1] * sigm(g1[1])); w.w = cvt_pk_bf16(v1[2] * sigm(g1[2]), v1[3] * sigm(g1[3]));
                    *(u32x4*)rowp = w; }
        } else {
            const int sec = pn < 2 ? 0 : (pn < 4 ? 1 : 3), colbase = 256 * (pn & 1); const bool act = pn >= 2;
            const int col0 = colbase + wc * 32 + 8 * fq; bf16_t* Ps = P + (size_t)sec * PSEC;
#pragma unroll
            for (int ai = 0; ai < 2; ++ai)
#pragma unroll
                for (int m = 0; m < 4; ++m) { bf16_t* rowp = Ps + (size_t)(row0 + ai * HALF + m * 16) * 512 + col0;
#pragma unroll
                    for (int bj = 0; bj < 2; ++bj) { f32x4 v0 = acc[ai][bj][m][0], v1 = acc[ai][bj][m][1];
                        if (act) {
#pragma unroll
                            for (int j = 0; j < 4; ++j) { v0[j] = silu(v0[j]); v1[j] = silu(v1[j]); } }
                        u32x4 w; w.x = cvt_pk_bf16(v0[0], v0[1]); w.y = cvt_pk_bf16(v0[2], v0[3]); w.z = cvt_pk_bf16(v1[0], v1[1]); w.w = cvt_pk_bf16(v1[2], v1[3]);
                        *(u32x4*)(rowp + bj * HALF) = w; } }
        }
    }
};
__device__ __forceinline__ float bf_lo(unsigned w) { return __uint_as_float(w << 16); }
__device__ __forceinline__ float bf_hi(unsigned w) { return __uint_as_float(w & 0xffff0000u); }
struct EpiPw {
    static constexpr bool PERM = true, AFTER_DRAIN = false;
    const bf16_t* P; bf16_t* Y; const float* bias;
    __device__ __forceinline__ void operator()(const f32x4 (&acc)[2][2][4][2], const Unit& u, int wr, int wc, int fr, int fq) const {
        const int row0 = u.pm * BM + wr * 64 + fr; const int col0 = u.pn * BM + wc * 32 + 8 * fq;
        f32x4 bv[2][2];
#pragma unroll
        for (int bj = 0; bj < 2; ++bj)
#pragma unroll
            for (int n = 0; n < 2; ++n) bv[bj][n] = *(const f32x4*)(bias + col0 + bj * HALF + 4 * n);
#pragma unroll
        for (int ai = 0; ai < 2; ++ai)
#pragma unroll
            for (int m = 0; m < 4; ++m) { const size_t row = (size_t)(row0 + ai * HALF + m * 16);
#pragma unroll
                for (int bj = 0; bj < 2; ++bj) { const u32x4 gt = *(const u32x4*)(P + 3 * PSEC + row * 512 + col0 + bj * HALF);
                    const f32x4 v0 = acc[ai][bj][m][0] + bv[bj][0], v1 = acc[ai][bj][m][1] + bv[bj][1];
                    u32x4 w; w.x = cvt_pk_bf16(v0[0] * bf_lo(gt.x), v0[1] * bf_hi(gt.x)); w.y = cvt_pk_bf16(v0[2] * bf_lo(gt.y), v0[3] * bf_hi(gt.y));
                    w.z = cvt_pk_bf16(v1[0] * bf_lo(gt.z), v1[1] * bf_hi(gt.z)); w.w = cvt_pk_bf16(v1[2] * bf_lo(gt.w), v1[3] * bf_hi(gt.w));
                    *(u32x4*)(Y + row * 1024 + 512 + col0 + bj * HALF) = w; } }
    }
};
struct EpiDelta {
    static constexpr bool PERM = true, AFTER_DRAIN = false;
    bf16_t* O;
    __device__ __forceinline__ void operator()(const f32x4 (&acc)[2][2][4][2], const Unit& u, int wr, int wc, int fr, int fq) const {
        const int row0 = u.pm * BM + wr * 64 + fr; const int col0 = u.pn * BM + wc * 32 + 8 * fq;
#pragma unroll
        for (int ai = 0; ai < 2; ++ai)
#pragma unroll
            for (int m = 0; m < 4; ++m) { bf16_t* rowp = O + (size_t)(row0 + ai * HALF + m * 16) * 1024 + col0;
#pragma unroll
                for (int bj = 0; bj < 2; ++bj) { const f32x4 v0 = acc[ai][bj][m][0], v1 = acc[ai][bj][m][1];
                    u32x4 w; w.x = cvt_pk_bf16(v0[0], v0[1]); w.y = cvt_pk_bf16(v0[2], v0[3]); w.z = cvt_pk_bf16(v1[0], v1[1]); w.w = cvt_pk_bf16(v1[2], v1[3]);
                    *(u32x4*)(rowp + bj * HALF) = w; } }
    }
};

template <class Epi, class Sched, bool ALIGN_EPI = false, bool SP2 = false>
__device__ __forceinline__ void gemm_phase(PG8_LAS unsigned char* lds, const Gemm g, const Sched& S, const Epi& E) {
    int tid_ = threadIdx.x; asm volatile("" : "+v"(tid_));
    const int tid = tid_, wid = __builtin_amdgcn_readfirstlane(tid >> 6), lane = tid & 63, wr = wid >> 2, wc = wid & 3, fr = lane & 15, fq = lane >> 4;
    const int K = g.K, nt = K / BK;
    unsigned voffA[2], voffB[2];
#pragma unroll
    for (int i = 0; i < 2; ++i) { int R, C; stage_rc(tid * 16 + i * 8192, R, C); const int Rb = Epi::PERM ? ((R & ~31) + perm32(R & 31)) : R;
        voffA[i] = (unsigned)(R * K + C) * 2u; voffB[i] = (unsigned)(Rb * K + C) * 2u; }
    const size_t kstep = (size_t)(BK * 2);
    const size_t hstep = (size_t)HALF * K * 2;
    const size_t tstep = 2 * hstep;
    const unsigned ldsw = (unsigned)wid * 1024u;
    const int aoff = lds_byte(wr * 64 + fr, fq * 8), boff = lds_byte(wc * 32 + fr, fq * 8);
#define PG8_SA(b, h) (((b) * 2 + (h)) * HTB)
#define PG8_SB(b, h) ((4 + (b) * 2 + (h)) * HTB)
#define PG8_STAGE(bufoff, gbase, voff) do { _Pragma("unroll") for (int _i = 0; _i < 2; ++_i) \
        __builtin_amdgcn_global_load_lds((const unsigned*)((const char*)(gbase) + (voff)[_i]), (PG8_LAS unsigned*)(lds + (bufoff) + ldsw + _i * 8192), 16, 0, 0); } while (0)
#define PG8_LDA(dst, b, h) do { _Pragma("unroll") for (int m = 0; m < 4; ++m) _Pragma("unroll") for (int k = 0; k < 2; ++k) dst[m][k] = *(const PG8_LAS bf16x8*)(lds + PG8_SA(b, h) + aoff + m * 2048 + k * 1024); } while (0)
#define PG8_LDB(dst, b, h) do { _Pragma("unroll") for (int n = 0; n < 2; ++n) _Pragma("unroll") for (int k = 0; k < 2; ++k) dst[n][k] = *(const PG8_LAS bf16x8*)(lds + PG8_SB(b, h) + boff + n * 2048 + k * 1024); } while (0)
#define PG8_MMA(ai, bj, At, Bt) do { __builtin_amdgcn_s_setprio(1); _Pragma("unroll") for (int m = 0; m < 4; ++m) _Pragma("unroll") for (int n = 0; n < 2; ++n) _Pragma("unroll") for (int k = 0; k < 2; ++k) \
        acc[ai][bj][m][n] = __builtin_amdgcn_mfma_f32_16x16x32_bf16(Bt[n][k], At[m][k], acc[ai][bj][m][n], 0, 0, 0); __builtin_amdgcn_s_setprio(0); } while (0)
#define PG8_WAIT_V(n) asm volatile("s_waitcnt vmcnt(" #n ")" ::: "memory")
#define PG8_WAIT_L(n) asm volatile("s_waitcnt lgkmcnt(" #n ")" ::: "memory")
#define PG8_BAR __builtin_amdgcn_s_barrier()
#define PG8_SCHED __builtin_amdgcn_sched_barrier(0)
    Unit cur, nxt; int ui = 0;
    if (!S.next(0, cur)) return;
    f32x4 acc[2][2][4][2];
#pragma unroll
    for (int a = 0; a < 2; ++a)
#pragma unroll
        for (int b = 0; b < 2; ++b)
#pragma unroll
            for (int m = 0; m < 4; ++m)
#pragma unroll
                for (int n = 0; n < 2; ++n) acc[a][b][m][n] = (f32x4){0.f, 0.f, 0.f, 0.f};
    bf16x8 At[4][2], B0[2][2], B1[2][2];
    const char* cA = (const char*)g.A + (size_t)cur.pm * tstep; const char* cB = (const char*)g.Bt + (size_t)cur.pn * tstep;
    S.a_ready(cur);
    if constexpr (SP2) {
        PG8_STAGE(PG8_SB(0, 0), cB, voffB); PG8_STAGE(PG8_SB(0, 1), cB + hstep, voffB); PG8_STAGE(PG8_SA(0, 0), cA, voffA); PG8_STAGE(PG8_SA(0, 1), cA + hstep, voffA);
        if (wr == 1) PG8_BAR;
        PG8_WAIT_V(2); PG8_BAR;
        PG8_STAGE(PG8_SB(1, 0), cB + kstep, voffB); PG8_STAGE(PG8_SA(1, 0), cA + kstep, voffA); PG8_STAGE(PG8_SB(1, 1), cB + hstep + kstep, voffB);
        PG8_WAIT_V(6); PG8_BAR;
    } else {
        PG8_STAGE(PG8_SB(0, 0), cB, voffB); PG8_STAGE(PG8_SA(0, 0), cA, voffA); PG8_STAGE(PG8_SB(0, 1), cB + hstep, voffB); PG8_STAGE(PG8_SA(0, 1), cA + hstep, voffA);
        if (wr == 1) PG8_BAR;
        PG8_WAIT_V(4); PG8_BAR;
        PG8_STAGE(PG8_SB(1, 0), cB + kstep, voffB); PG8_STAGE(PG8_SA(1, 0), cA + kstep, voffA); PG8_STAGE(PG8_SB(1, 1), cB + hstep + kstep, voffB);
        PG8_WAIT_V(6); PG8_BAR;
    }
    for (;;) {
        const bool has_next = S.next(ui + 1, nxt);
        const char* nA = has_next ? (const char*)g.A + (size_t)nxt.pm * tstep : cA; const char* nB = has_next ? (const char*)g.Bt + (size_t)nxt.pn * tstep : cB;
        for (int t = 0; t < nt; t += 2) {
            const bool last = (t == nt - 2);
            const char* a1 = cA + (size_t)(t + 1) * kstep;
            const char* a2 = last ? nA : cA + (size_t)(t + 2) * kstep; const char* b2 = last ? nB : cB + (size_t)(t + 2) * kstep;
            const char* a3 = a2 + kstep; const char* b3 = b2 + kstep;
            if (last && has_next) S.a_ready(nxt);
            if constexpr (SP2) {
            PG8_LDB(B0, 0, 0); PG8_LDB(B1, 0, 1); PG8_SCHED; PG8_LDA(At, 0, 0); PG8_STAGE(PG8_SA(1, 1), a1 + hstep, voffA);
            PG8_WAIT_V(8); PG8_WAIT_L(0); PG8_BAR; PG8_MMA(0, 0, At, B0); PG8_MMA(0, 1, At, B1); PG8_BAR; PG8_SCHED;
            PG8_LDA(At, 0, 1); PG8_STAGE(PG8_SB(0, 0), b2, voffB); PG8_STAGE(PG8_SB(0, 1), b2 + hstep, voffB); PG8_STAGE(PG8_SA(0, 0), a2, voffA);
            PG8_WAIT_V(8); PG8_WAIT_L(0); PG8_BAR; PG8_MMA(1, 0, At, B0); PG8_MMA(1, 1, At, B1); PG8_BAR; PG8_SCHED;
            PG8_LDB(B0, 1, 0); PG8_LDB(B1, 1, 1); PG8_SCHED; PG8_LDA(At, 1, 0); PG8_STAGE(PG8_SA(0, 1), a2 + hstep, voffA);
            PG8_WAIT_V(8); PG8_WAIT_L(0); PG8_BAR; PG8_MMA(0, 0, At, B0); PG8_MMA(0, 1, At, B1); PG8_BAR; PG8_SCHED;
            PG8_LDA(At, 1, 1); PG8_STAGE(PG8_SB(1, 0), b3, voffB); PG8_STAGE(PG8_SB(1, 1), b3 + hstep, voffB); PG8_STAGE(PG8_SA(1, 0), a3, voffA);
            PG8_WAIT_V(8); PG8_WAIT_L(0); PG8_BAR; PG8_MMA(1, 0, At, B0); PG8_MMA(1, 1, At, B1); PG8_BAR; PG8_SCHED;
            } else {
            PG8_LDB(B0, 0, 0); PG8_SCHED; PG8_LDA(At, 0, 0); PG8_STAGE(PG8_SA(1, 1), a1 + hstep, voffA);
            PG8_WAIT_L(8); PG8_BAR; PG8_WAIT_L(0); PG8_MMA(0, 0, At, B0); PG8_BAR; PG8_SCHED;
            PG8_LDB(B1, 0, 1); PG8_STAGE(PG8_SB(0, 0), b2, voffB);
            PG8_BAR; PG8_WAIT_L(0); PG8_MMA(0, 1, At, B1); PG8_BAR;
            PG8_LDA(At, 0, 1); PG8_STAGE(PG8_SA(0, 0), a2, voffA);
            PG8_BAR; PG8_WAIT_L(0); PG8_MMA(1, 0, At, B0); PG8_BAR; PG8_SCHED;
            PG8_STAGE(PG8_SB(0, 1), b2 + hstep, voffB);
            PG8_WAIT_V(6); PG8_BAR; PG8_MMA(1, 1, At, B1); PG8_BAR;
            PG8_LDB(B0, 1, 0); PG8_SCHED; PG8_LDA(At, 1, 0); PG8_STAGE(PG8_SA(0, 1), a2 + hstep, voffA);
            PG8_WAIT_L(8); PG8_BAR; PG8_WAIT_L(0); PG8_MMA(0, 0, At, B0); PG8_BAR; PG8_SCHED;
            PG8_LDB(B1, 1, 1); PG8_STAGE(PG8_SB(1, 0), b3, voffB);
            PG8_BAR; PG8_WAIT_L(0); PG8_MMA(0, 1, At, B1); PG8_BAR;
            PG8_LDA(At, 1, 1); PG8_STAGE(PG8_SA(1, 0), a3, voffA);
            PG8_BAR; PG8_WAIT_L(0); PG8_MMA(1, 0, At, B0); PG8_BAR; PG8_SCHED;
            PG8_STAGE(PG8_SB(1, 1), b3 + hstep, voffB);
            PG8_WAIT_V(6); PG8_BAR; PG8_MMA(1, 1, At, B1); PG8_BAR;
            }
        }
        if constexpr (ALIGN_EPI) { if (wr == 0) PG8_BAR; }
        if constexpr (!Epi::AFTER_DRAIN) { E(acc, cur, wr, wc, fr, fq); S.done(cur); }
        if (!has_next) break;
#pragma unroll
        for (int a = 0; a < 2; ++a)
#pragma unroll
            for (int b = 0; b < 2; ++b)
#pragma unroll
                for (int m = 0; m < 4; ++m)
#pragma unroll
                    for (int n = 0; n < 2; ++n) acc[a][b][m][n] = (f32x4){0.f, 0.f, 0.f, 0.f};
        cur = nxt; cA = nA; cB = nB; ++ui;
        if constexpr (ALIGN_EPI) { if (wr == 1) PG8_BAR; }
    }
    PG8_WAIT_V(0);
    if constexpr (!ALIGN_EPI) { if (wr == 0) PG8_BAR; }
    PG8_BAR;
    if constexpr (Epi::AFTER_DRAIN) { E.fused(acc, cur, wr, wc, fr, fq, lds, wid, lane); S.done(cur); }
#undef PG8_SA
#undef PG8_SB
#undef PG8_STAGE
#undef PG8_LDA
#undef PG8_LDB
#undef PG8_MMA
#undef PG8_WAIT_V
#undef PG8_WAIT_L
#undef PG8_BAR
#undef PG8_SCHED
}
}

constexpr int MTOK = 16 * 2048, SEQ = 2048, DM = 1024, DIN = 2560, WP = 512, WC = 512;
constexpr int MISC_OFF = 131072, LDS_BYTES = 131072 + 256, NTHR = 512;
constexpr size_t WS_WIN = 0, WS_PW = WS_WIN + (size_t)DIN * DM * 2, WS_WOUT = WS_PW + (size_t)WC * WC * 2, WS_HN = WS_WOUT + (size_t)DM * DM * 2,
                 WS_P = WS_HN + (size_t)MTOK * DM * 2, WS_HC = WS_P + (size_t)MTOK * 2048 * 2, WS_Y = WS_HC + (size_t)MTOK * WC * 2, WS_PART = WS_Y + (size_t)MTOK * DM * 2,
                 WS_BAR = WS_PART + (size_t)MTOK * 16 * 4, WS_DELTA = WS_HN  , WS_END = WS_BAR + 16384;
#define LAS __attribute__((address_space(3)))
typedef unsigned short bf16;
typedef float f32x4 __attribute__((ext_vector_type(4)));
typedef float f32x2 __attribute__((ext_vector_type(2)));
typedef unsigned u32x4 __attribute__((ext_vector_type(4)));
typedef unsigned u32x2 __attribute__((ext_vector_type(2)));
#define LDS_WAIT() asm volatile("s_waitcnt lgkmcnt(0)" ::: "memory")
using pg8::cvt_pk_bf16; using pg8::silu; using pg8::bf_lo; using pg8::bf_hi;

#define RLX_AGENT __ATOMIC_RELAXED, __HIP_MEMORY_SCOPE_AGENT
#define XB_TMO      128
#define XB_XCNT(j)  (256  + 64 * (j))
#define XB_XSUB(j)  (1280 + 64 * (j))
#define XB_XGEN(j)  (2304 + 64 * (j))
#define XB_TOP      3328
#define XB_TOPGEN   3392
#define XCD_BAR_WORDS 3456
#define XB_SPIN_CAP (1u << 18)

__device__ __forceinline__ unsigned xb_ld(unsigned* p)              { return __hip_atomic_load(p, __ATOMIC_RELAXED, __HIP_MEMORY_SCOPE_AGENT); }
__device__ __forceinline__ unsigned xb_add(unsigned* p, unsigned v) { return __hip_atomic_fetch_add(p, v, __ATOMIC_RELAXED, __HIP_MEMORY_SCOPE_AGENT); }
__device__ __forceinline__ unsigned xb_xcc_id() { return (unsigned)__builtin_amdgcn_s_getreg((3 << 11) | 20) & 0xFu; }
#define XB_SPIN(cond, bar) do { unsigned _sp = 0; while (cond) { __builtin_amdgcn_s_sleep(1); \
    if ((++_sp & 255u) == 0u) { if (xb_ld(&(bar)[XB_TMO])) break; if (_sp > XB_SPIN_CAP) { atomicAdd(&(bar)[XB_TMO], 1u); break; } } } } while (0)

struct XcdBarrier {
    unsigned* bar; unsigned x;
    volatile LAS unsigned* st;
};

__device__ __forceinline__ XcdBarrier xcd_barrier_post(unsigned* bar, volatile LAS unsigned* st) {
    XcdBarrier b; b.bar = bar; b.x = xb_xcc_id(); b.st = st;
    if (threadIdx.x == 0) (void)xb_add(&bar[XB_XCNT(b.x)], 1u);
    return b;
}
__device__ __forceinline__ void xcd_barrier_complete(unsigned* bar, unsigned x, unsigned& nloc, unsigned& nx) {
    const unsigned G = gridDim.x * gridDim.y * gridDim.z;
    unsigned sum, cnt, mine, sp = 0u;
    for (;;) {
        sum = 0u; cnt = 0u; mine = 0u;
#pragma unroll
        for (unsigned j = 0; j < 16; ++j) { const unsigned c = xb_ld(&bar[XB_XCNT(j)]); sum += c; cnt += (c > 0u) ? 1u : 0u; mine = (j == x) ? c : mine; }
        if (sum == G) break;
        __builtin_amdgcn_s_sleep(1);
        if ((++sp & 255u) == 0u) { if (xb_ld(&bar[XB_TMO])) break; if (sp > XB_SPIN_CAP) { atomicAdd(&bar[XB_TMO], 1u); break; } }
    }
    nloc = mine > 0u ? mine : 1u; nx = cnt > 0u ? cnt : 1u;
}

__device__ __forceinline__ void xcd_barrier(const XcdBarrier& b) {
    asm volatile("s_waitcnt vmcnt(0)" ::: "memory");
    __syncthreads();
    if (threadIdx.x == 0) {
        unsigned* bar = b.bar;
        __builtin_amdgcn_s_waitcnt(0);
        unsigned nloc = b.st[0], nx = b.st[1];
        if (nloc == 0u) { xcd_barrier_complete(bar, b.x, nloc, nx); b.st[0] = nloc; b.st[1] = nx; }
        const unsigned old = xb_add(&bar[XB_XSUB(b.x)], 1u);
        const unsigned gen = old / nloc;
        if (old + 1u == (gen + 1u) * nloc) {
            __builtin_amdgcn_fence(__ATOMIC_RELEASE, "agent");
            asm volatile("s_waitcnt vmcnt(0)" ::: "memory");
            const unsigned og = xb_add(&bar[XB_TOP], 1u);
            const unsigned tg = og / nx;
            if (og + 1u == (tg + 1u) * nx) xb_add(&bar[XB_TOPGEN], 1u);
            else XB_SPIN(xb_ld(&bar[XB_TOPGEN]) == tg, bar);
            __builtin_amdgcn_fence(__ATOMIC_ACQUIRE, "agent");
            xb_add(&bar[XB_XGEN(b.x)], 1u);
            asm volatile("s_waitcnt vmcnt(0)" ::: "memory");
        } else {
            XB_SPIN(xb_ld(&bar[XB_XGEN(b.x)]) == gen, bar);
            __builtin_amdgcn_fence(__ATOMIC_ACQUIRE, "agent");
            asm volatile("s_waitcnt vmcnt(0)" ::: "memory");
        }
    }
    __syncthreads();
}

struct Params {
    const float *x, *norm_g, *w_in, *pool_w, *pool_b, *pool_scale, *conv_dw, *conv_b, *ln_g, *ln_b, *pw_w, *pw_b, *w_out, *final_g;
    float* out; unsigned char* ws;
};

__device__ __forceinline__ float wave_sum(float v) {
#pragma unroll
    for (int o = 1; o < 64; o <<= 1) v += __shfl_xor(v, o);
    return v;
}
__device__ __forceinline__ float wave_sum_dpp(float v) {
#define DPP_ADD(ctrl) v += __builtin_bit_cast(float, __builtin_amdgcn_update_dpp(0, __builtin_bit_cast(int, v), (ctrl), 0xf, 0xf, true))
    DPP_ADD(0xB1);
    DPP_ADD(0x4E);
    DPP_ADD(0x141);
    DPP_ADD(0x140);
#undef DPP_ADD
    const int b = __builtin_bit_cast(int, v);
    return (__builtin_bit_cast(float, __builtin_amdgcn_readlane(b, 0)) + __builtin_bit_cast(float, __builtin_amdgcn_readlane(b, 16))) + (__builtin_bit_cast(float, __builtin_amdgcn_readlane(b, 32)) + __builtin_bit_cast(float, __builtin_amdgcn_readlane(b, 48)));
}
__device__ __forceinline__ void wave_sum_dpp4(float (&v)[4]) {
#define DPP_ADD4(ctrl) _Pragma("unroll") for (int i = 0; i < 4; ++i) v[i] += __builtin_bit_cast(float, __builtin_amdgcn_update_dpp(0, __builtin_bit_cast(int, v[i]), (ctrl), 0xf, 0xf, true))
    DPP_ADD4(0xB1); DPP_ADD4(0x4E); DPP_ADD4(0x141); DPP_ADD4(0x140);
#undef DPP_ADD4
#pragma unroll
    for (int i = 0; i < 4; ++i) { const int b = __builtin_bit_cast(int, v[i]);
        v[i] = (__builtin_bit_cast(float, __builtin_amdgcn_readlane(b, 0)) + __builtin_bit_cast(float, __builtin_amdgcn_readlane(b, 16))) + (__builtin_bit_cast(float, __builtin_amdgcn_readlane(b, 32)) + __builtin_bit_cast(float, __builtin_amdgcn_readlane(b, 48))); }
}
__device__ __forceinline__ void transpose_item(const float* W, int ldw, int scol0, int k0, bf16* WT, int ldt, int drow0, LAS float* scr, int lane) {
    float tv[32];
#pragma unroll
    for (int i = 0; i < 32; ++i) tv[i] = W[(size_t)(k0 + 2 * i + (lane >> 5)) * ldw + scol0 + (lane & 31)];
#pragma unroll
    for (int i = 0; i < 32; ++i) scr[(2 * i + (lane >> 5)) * 33 + (lane & 31)] = tv[i];
    LDS_WAIT();
    const int c = lane & 7;
#pragma unroll
    for (int j = 0; j < 4; ++j) { const int n = (lane >> 3) + 8 * j; const LAS float* s = scr + (8 * c) * 33 + n;
        u32x4 o; o.x = cvt_pk_bf16(s[0 * 33], s[1 * 33]); o.y = cvt_pk_bf16(s[2 * 33], s[3 * 33]); o.z = cvt_pk_bf16(s[4 * 33], s[5 * 33]); o.w = cvt_pk_bf16(s[6 * 33], s[7 * 33]);
        *(u32x4*)(WT + (size_t)(drow0 + n) * ldt + k0 + 8 * c) = o; }
    LDS_WAIT();
}
__device__ __forceinline__ void poolfold_wg(const float* w_in, const float* pool_w, bf16* WinT, int g, int k0, LAS unsigned char* lds, int tid, int wave, int lane) {
    LAS float* pw = (LAS float*)lds;
    LAS float* wi = (LAS float*)(lds + 65536);
    const f32x4* src = (const f32x4*)(pool_w + (size_t)g * 128 * 128) + tid; f32x4 t[8];
#pragma unroll
    for (int i = 0; i < 8; ++i) t[i] = src[i * NTHR];
    const f32x4 wv = *(const f32x4*)(w_in + (size_t)(k0 + (tid >> 5)) * DIN + 128 * g + 4 * (tid & 31));
#pragma unroll
    for (int i = 0; i < 8; ++i) *((LAS f32x4*)pw + tid + i * NTHR) = t[i];
    *((LAS f32x4*)wi + tid) = wv;
    __syncthreads();
    float a00 = 0.f, a01 = 0.f, a10 = 0.f, a11 = 0.f;
    const LAS float* w0 = wi + (2 * wave) * 128; const LAS float* w1 = w0 + 128;
#pragma unroll 4
    for (int c4 = 0; c4 < 32; ++c4) { const f32x4 x0 = *(const LAS f32x4*)(w0 + 4 * c4), x1 = *(const LAS f32x4*)(w1 + 4 * c4);
#pragma unroll
        for (int cc = 0; cc < 4; ++cc) { const float p0 = pw[(4 * c4 + cc) * 128 + lane], p1 = pw[(4 * c4 + cc) * 128 + 64 + lane];
            a00 += x0[cc] * p0; a01 += x0[cc] * p1; a10 += x1[cc] * p0; a11 += x1[cc] * p1; } }
    *(unsigned*)(WinT + (size_t)(128 * g + lane) * DM + k0 + 2 * wave) = cvt_pk_bf16(a00, a10);
    *(unsigned*)(WinT + (size_t)(128 * g + 64 + lane) * DM + k0 + 2 * wave) = cvt_pk_bf16(a01, a11);
    __syncthreads();
}

__device__ __forceinline__ void phase_prep(const Params& p, LAS unsigned char* lds, int bid, int G) {
    int tid_ = threadIdx.x; asm volatile("" : "+v"(tid_)); const int tid = tid_, lane = tid & 63, wave = __builtin_amdgcn_readfirstlane(tid >> 6);
    LAS float* scr = (LAS float*)(lds + wave * 8704);
    bf16* WinT = (bf16*)(p.ws + WS_WIN); bf16* PwT = (bf16*)(p.ws + WS_PW); bf16* WoutT = (bf16*)(p.ws + WS_WOUT); bf16* HN = (bf16*)(p.ws + WS_HN);
    const int gw = bid * 8 + wave, NGW = G * 8;
    for (int t = bid; t < 256; t += G) poolfold_wg(p.w_in, p.pool_w, WinT, t & 3, 16 * (t >> 2), lds, tid, wave, lane);
    if (wave < 2) for (int t = bid + G * wave; t < 1664; t += 2 * G) {
        if (t < 1024) { const int kb = t >> 6, nb = t & 63, n = 512 + 32 * nb; int scol;
            if (n < 1024 || n >= 2048) scol = n; else { const int q = (n - 1024) >> 8, r = (n - 1024) & 255; scol = r < 128 ? 1024 + 128 * q + r : 1536 + 128 * q + (r - 128); }
            transpose_item(p.w_in, DIN, scol, 64 * kb, WinT, DM, n, scr, lane); }
        else if (t < 1152) { const int it = t - 1024, kb = it >> 4, nb = it & 15; transpose_item(p.pw_w, WC, 32 * nb, 64 * kb, PwT, WC, 32 * nb, scr, lane); }
        else { const int it = t - 1152, kb = it >> 5, nb = it & 31; transpose_item(p.w_out, DM, 32 * nb, 64 * kb, WoutT, DM, 32 * nb, scr, lane); }
    }
    f32x4 gv[4];
#pragma unroll
    for (int j = 0; j < 4; ++j) gv[j] = *((const f32x4*)p.norm_g + lane + 64 * j);
    LAS int* ticket = (LAS int*)(lds + MISC_OFF + 64);
    for (;;) {
        int c = 0; if (lane == 0) c = __hip_atomic_fetch_add(ticket, 1, __ATOMIC_RELAXED, __HIP_MEMORY_SCOPE_WORKGROUP);
        c = __builtin_amdgcn_readfirstlane(c);
        const int m0 = 4 * (bid + G * c); if (m0 >= MTOK) break;
        const f32x4* xr = (const f32x4*)(p.x + (size_t)m0 * DM) + lane; f32x4 v[4][4];
#pragma unroll
        for (int r = 0; r < 4; ++r)
#pragma unroll
            for (int j = 0; j < 4; ++j) v[r][j] = __builtin_nontemporal_load(xr + r * 256 + 64 * j);
        __builtin_amdgcn_sched_barrier(0);
#pragma unroll
        for (int r = 0; r < 4; ++r) { float s = 0.f;
#pragma unroll
            for (int j = 0; j < 4; ++j) s += (v[r][j].x * v[r][j].x + v[r][j].y * v[r][j].y) + (v[r][j].z * v[r][j].z + v[r][j].w * v[r][j].w);
            const float rs = 1.0f / sqrtf(wave_sum_dpp(s) * (1.0f / DM) + 1e-6f);
            u32x2* o8 = (u32x2*)(HN + (size_t)(m0 + r) * DM) + lane;
#pragma unroll
            for (int j = 0; j < 4; ++j) { const f32x4 y = v[r][j] * rs * gv[j]; u32x2 w; w.x = cvt_pk_bf16(y.x, y.y); w.y = cvt_pk_bf16(y.z, y.w); o8[64 * j] = w; } }
    }
}

__device__ __forceinline__ void mixer_load_h(const bf16* P, int tile, int wave, int lane, u32x4 (&hv)[8]) {
    const int t0 = tile * 32, s0 = t0 & (SEQ - 1);
#pragma unroll
    for (int k = 0; k < 8; ++k) { const int r = wave + 8 * k; const bool ok = (s0 - 30 + r >= 0) && (r < 62);
        const u32x4 v = *(const u32x4*)(P + 2 * pg8::PSEC + (size_t)(ok ? t0 - 30 + r : t0) * 512 + lane * 8);
        hv[k] = ok ? v : (u32x4){0u, 0u, 0u, 0u}; }
}
#define GAS __attribute__((address_space(1)))
#define FMAC(acc, x_, y_) asm("v_fmac_f32 %0, %1, %2" : "+v"(acc) : "v"(x_), "v"(y_))
template <int W> __device__ __forceinline__ void pool_compute(const unsigned (&ur)[31], const unsigned (&ag)[16], int sa, f32x2 pb, f32x2 ps, bf16* yp) {
    float s0 = 0.f, s1 = 0.f;
#pragma unroll
    for (int i = 16 - W; i <= 15; ++i) { s0 += bf_lo(ur[i]); s1 += bf_hi(ur[i]); }
#pragma unroll
    for (int r = 0; r < 16; ++r) {
        if (r > 0) { s0 += bf_lo(ur[15 + r]) - bf_lo(ur[15 + r - W]); s1 += bf_hi(ur[15 + r]) - bf_hi(ur[15 + r - W]); }
        const int cnt = sa + r + 1 < W ? sa + r + 1 : W; const float inv = __builtin_amdgcn_rcpf((float)cnt);
        const float z0 = s0 * inv - bf_lo(ur[15 + r]) + pb.x, z1 = s1 * inv - bf_hi(ur[15 + r]) + pb.y;
        *(unsigned*)(yp + (size_t)r * DM) = cvt_pk_bf16(z0 * ps.x * bf_lo(ag[r]), z1 * ps.y * bf_hi(ag[r]));
    }
}
__device__ __forceinline__ void phase_mixer(const Params& p, LAS unsigned char* lds, int bid, int G) {
    int tid_ = threadIdx.x; asm volatile("" : "+v"(tid_)); const int tid = tid_, lane = tid & 63, wave = __builtin_amdgcn_readfirstlane(tid >> 6);
    const bf16* P = (const bf16*)(p.ws + WS_P); bf16* HC = (bf16*)(p.ws + WS_HC); bf16* Y = (bf16*)(p.ws + WS_Y);
    LAS unsigned char* Hs = lds;
    LAS float* Cs = (LAS float*)(lds + 62 * 1024);
    const int cp = tid & 255, th = tid >> 8;
    const int pgp = wave & 3, pth = wave >> 2, pw_ = 2 << pgp, pc0 = 128 * pgp + 2 * lane;
    const f32x2 pb = *(const f32x2*)(p.pool_b + pc0), ps = *(const f32x2*)(p.pool_scale + pc0);
    const f32x4 lg0 = *(const f32x4*)(p.ln_g + 4 * lane), lg1 = *(const f32x4*)(p.ln_g + 256 + 4 * lane), lb0 = *(const f32x4*)(p.ln_b + 4 * lane), lb1 = *(const f32x4*)(p.ln_b + 256 + 4 * lane);
    const f32x2 cb = *(const f32x2*)(p.conv_b + 2 * cp);
    const int NT = MTOK / 32;
    f32x2 tw[31];
#pragma unroll
    for (int j = 0; j < 31; ++j) tw[j] = *(const f32x2*)(p.conv_dw + j * WC + 2 * cp);
    u32x4 hv[8];
    const bool xo = (G == 256); const int tbase = xo ? 128 * (bid & 7) + (bid >> 3) : bid, tstep_ = xo ? 32 : G, ntrip = xo ? 4 : (NT - bid + G - 1) / G;
    if (ntrip > 0) mixer_load_h(P, tbase, wave, lane, hv);
    for (int it = 0; it < ntrip; ++it) { const int tile = tbase + it * tstep_;
        const int t0 = tile * 32, s0 = t0 & (SEQ - 1);
        const int ta = t0 + 16 * pth, sa = s0 + 16 * pth;
#pragma unroll
        for (int k = 0; k < 8; ++k) { const int r = wave + 8 * k; if (r < 62) *(LAS u32x4*)(Hs + r * 1024 + lane * 16) = hv[k]; }
        unsigned ur[31], ag[16];
#pragma unroll
        for (int i = 0; i < 31; ++i) { const bool ok = (i >= 16 - pw_) && (sa - 15 + i >= 0);
            const unsigned v = *(const unsigned*)(P + (size_t)(ok ? ta - 15 + i : ta) * 512 + pc0); ur[i] = ok ? v : 0u; }
#pragma unroll
        for (int r = 0; r < 16; ++r) ag[r] = *(const unsigned*)(P + pg8::PSEC + (size_t)(ta + r) * 512 + pc0);
        if (it + 1 < ntrip) mixer_load_h(P, tile + tstep_, wave, lane, hv);
        __builtin_amdgcn_sched_barrier(0);
        __syncthreads();
        {
            float a0[16], a1[16];
#pragma unroll
            for (int r = 0; r < 16; ++r) { a0[r] = cb.x; a1[r] = cb.y; }
            const LAS unsigned* hp = (const LAS unsigned*)(Hs + (th * 16) * 1024 + cp * 4);
#pragma unroll
            for (int i = 0; i < 46; ++i) { const unsigned w = hp[i * 256]; const float v0 = bf_lo(w), v1 = bf_hi(w);
#pragma unroll
                for (int r = 0; r < 16; ++r) { const int j = i - r; if (j >= 0 && j <= 30) { FMAC(a0[r], tw[j].x, v0); FMAC(a1[r], tw[j].y, v1); } } }
#pragma unroll
            for (int r = 0; r < 16; ++r) *(LAS f32x2*)(Cs + (th * 16 + r) * 512 + 2 * cp) = (f32x2){a0[r], a1[r]};
        }
        __builtin_amdgcn_sched_barrier(0);
        __syncthreads();
        {
            f32x4 v0[4], v1[4]; float sa4[4];
#pragma unroll
            for (int rr = 0; rr < 4; ++rr) { const int row = 4 * wave + rr;
                v0[rr] = *(const LAS f32x4*)(Cs + row * 512 + 4 * lane); v1[rr] = *(const LAS f32x4*)(Cs + row * 512 + 256 + 4 * lane);
                sa4[rr] = ((v0[rr].x + v0[rr].y) + (v0[rr].z + v0[rr].w)) + ((v1[rr].x + v1[rr].y) + (v1[rr].z + v1[rr].w)); }
            wave_sum_dpp4(sa4);
#pragma unroll
            for (int rr = 0; rr < 4; ++rr) { const float mean = sa4[rr] * (1.0f / 512.0f); v0[rr] = v0[rr] - mean; v1[rr] = v1[rr] - mean;
                sa4[rr] = ((v0[rr].x * v0[rr].x + v0[rr].y * v0[rr].y) + (v0[rr].z * v0[rr].z + v0[rr].w * v0[rr].w)) + ((v1[rr].x * v1[rr].x + v1[rr].y * v1[rr].y) + (v1[rr].z * v1[rr].z + v1[rr].w * v1[rr].w)); }
            wave_sum_dpp4(sa4);
#pragma unroll
            for (int rr = 0; rr < 4; ++rr) { const int row = 4 * wave + rr; const float rstd = __builtin_amdgcn_rsqf(sa4[rr] * (1.0f / 512.0f) + 1e-5f);
                const f32x4 y0 = v0[rr] * rstd * lg0 + lb0, y1 = v1[rr] * rstd * lg1 + lb1;
                u32x2 w0, w1; w0.x = cvt_pk_bf16(silu(y0.x), silu(y0.y)); w0.y = cvt_pk_bf16(silu(y0.z), silu(y0.w)); w1.x = cvt_pk_bf16(silu(y1.x), silu(y1.y)); w1.y = cvt_pk_bf16(silu(y1.z), silu(y1.w));
                bf16* o = HC + (size_t)(t0 + row) * WC; *(u32x2*)(o + 4 * lane) = w0; *(u32x2*)(o + 256 + 4 * lane) = w1; }
        }
        __builtin_amdgcn_sched_barrier(0);
        { bf16* yp = Y + (size_t)ta * DM + pc0;
          if (pgp == 0) pool_compute<2>(ur, ag, sa, pb, ps, yp); else if (pgp == 1) pool_compute<4>(ur, ag, sa, pb, ps, yp);
          else if (pgp == 2) pool_compute<8>(ur, ag, sa, pb, ps, yp); else pool_compute<16>(ur, ag, sa, pb, ps, yp); }
    }
    __syncthreads();
}

__device__ __forceinline__ void phase_final(const Params& p, int bid, int G) {
    int tid_ = threadIdx.x; asm volatile("" : "+v"(tid_)); const int tid = tid_, lane = tid & 63, wave = __builtin_amdgcn_readfirstlane(tid >> 6);
    const bf16* DL = (const bf16*)(p.ws + WS_DELTA);
    const int gw = bid * 8 + wave, NGW = G * 8;
    f32x4 gv[4];
#pragma unroll
    for (int j = 0; j < 4; ++j) gv[j] = *((const f32x4*)p.final_g + lane + 64 * j);
    for (int m0 = gw * 4; m0 < MTOK; m0 += NGW * 4) {
        const f32x4* xr = (const f32x4*)(p.x + (size_t)m0 * DM) + lane; const u32x2* dr = (const u32x2*)(DL + (size_t)m0 * DM) + lane;
        f32x4 v[4][4]; u32x2 d[4][4];
#pragma unroll
        for (int r = 0; r < 4; ++r)
#pragma unroll
            for (int j = 0; j < 4; ++j) { v[r][j] = __builtin_nontemporal_load(xr + r * 256 + 64 * j); d[r][j] = dr[r * 256 + 64 * j]; }
        __builtin_amdgcn_sched_barrier(0);
#pragma unroll
        for (int r = 0; r < 4; ++r) { float s = 0.f;
#pragma unroll
            for (int j = 0; j < 4; ++j) { v[r][j].x += bf_lo(d[r][j].x); v[r][j].y += bf_hi(d[r][j].x); v[r][j].z += bf_lo(d[r][j].y); v[r][j].w += bf_hi(d[r][j].y);
                s += (v[r][j].x * v[r][j].x + v[r][j].y * v[r][j].y) + (v[r][j].z * v[r][j].z + v[r][j].w * v[r][j].w); }
            const float rs = 1.0f / sqrtf(wave_sum_dpp(s) * (1.0f / DM) + 1e-6f);
            f32x4* o = (f32x4*)(p.out + (size_t)(m0 + r) * DM) + lane;
#pragma unroll
            for (int j = 0; j < 4; ++j) o[64 * j] = v[r][j] * rs * gv[j]; }
    }
}

__global__ void __launch_bounds__(NTHR, 2) fwd_mega(Params p) {
    extern __shared__ __attribute__((aligned(16))) unsigned char lds_raw[];
    LAS unsigned char* lds = (LAS unsigned char*)lds_raw;
    const int bid = blockIdx.x, G = gridDim.x;
    const bf16* WinT = (const bf16*)(p.ws + WS_WIN); const bf16* PwT = (const bf16*)(p.ws + WS_PW); const bf16* WoutT = (const bf16*)(p.ws + WS_WOUT);
    const bf16* HN = (const bf16*)(p.ws + WS_HN); bf16* P = (bf16*)(p.ws + WS_P); const bf16* HC = (const bf16*)(p.ws + WS_HC); bf16* Y = (bf16*)(p.ws + WS_Y);
    bf16* DL = (bf16*)(p.ws + WS_DELTA);

    volatile LAS unsigned* MISC = (volatile LAS unsigned*)(lds + MISC_OFF);
    if (threadIdx.x < 64) MISC[threadIdx.x] = 0u;
    __syncthreads();
    XcdBarrier bar = xcd_barrier_post((unsigned*)(p.ws + WS_BAR), MISC + 8);
#define GSYNC() xcd_barrier(bar)
    phase_prep(p, lds, bid, G);
    GSYNC();
    {
        pg8::Gemm g{HN, WinT, MTOK, DIN, DM}; pg8::StaticOrder S; S.init(MTOK, DIN, G, bid);
        pg8::EpiProj E{P};
        pg8::gemm_phase<pg8::EpiProj, pg8::StaticOrder, true, true>(lds, g, S, E);
    }
    GSYNC();
    phase_mixer(p, lds, bid, G);
    GSYNC();
    {
        pg8::Gemm g{HC, PwT, MTOK, WC, WC}; pg8::StaticOrder S; S.init(MTOK, WC, G, bid);
        pg8::EpiPw E{P, Y, p.pw_b};
        pg8::gemm_phase<pg8::EpiPw, pg8::StaticOrder, true, true>(lds, g, S, E);
    }
    GSYNC();
    {
        pg8::Gemm g{Y, WoutT, MTOK, DM, DM}; pg8::StaticOrder S; S.init(MTOK, DM, G, bid);
        pg8::EpiDelta E{DL};
        pg8::gemm_phase<pg8::EpiDelta, pg8::StaticOrder, true, true>(lds, g, S, E);
    }
    GSYNC();
    phase_final(p, bid, G);
}

extern "C" void kernel_launch(void* const* d_in, const int* in_sizes, int n_in, void* d_out, int out_size, void* d_ws, size_t ws_size, hipStream_t stream) {
    static int grid_blocks = 0;
    if (grid_blocks == 0) {
        if (n_in != 14 || in_sizes[0] != MTOK * DM || out_size != MTOK * DM || ws_size < WS_END) { fprintf(stderr, "kernel_launch: unexpected shapes (n_in %d, ws %zu)\n", n_in, ws_size); grid_blocks = -1; return; }
        int dev = 0, cus = 0, per_cu = 0;
        (void)hipGetDevice(&dev); (void)hipDeviceGetAttribute(&cus, hipDeviceAttributeMultiprocessorCount, dev);
        if (hipFuncSetAttribute((const void*)fwd_mega, hipFuncAttributeMaxDynamicSharedMemorySize, LDS_BYTES) != hipSuccess) { fprintf(stderr, "kernel_launch: hipFuncSetAttribute failed\n"); grid_blocks = -1; return; }
        if (hipOccupancyMaxActiveBlocksPerMultiprocessor(&per_cu, (const void*)fwd_mega, NTHR, LDS_BYTES) != hipSuccess || per_cu < 1) { fprintf(stderr, "kernel_launch: occupancy query failed (%d)\n", per_cu); (void)hipGetLastError(); per_cu = 1; }
        if (per_cu > 1) per_cu = 1;
        grid_blocks = cus * per_cu;
    }
    if (grid_blocks < 0) return;
    Params p{};
    p.x = (const float*)d_in[0]; p.norm_g = (const float*)d_in[1]; p.w_in = (const float*)d_in[2]; p.pool_w = (const float*)d_in[3]; p.pool_b = (const float*)d_in[4];
    p.pool_scale = (const float*)d_in[5]; p.conv_dw = (const float*)d_in[6]; p.conv_b = (const float*)d_in[7]; p.ln_g = (const float*)d_in[8]; p.ln_b = (const float*)d_in[9];
    p.pw_w = (const float*)d_in[10]; p.pw_b = (const float*)d_in[11]; p.w_out = (const float*)d_in[12]; p.final_g = (const float*)d_in[13];
    p.out = (float*)d_out; p.ws = (unsigned char*)d_ws;
    if (hipMemsetAsync((char*)d_ws + WS_BAR, 0, 16384, stream) != hipSuccess) { fprintf(stderr, "kernel_launch: memset failed\n"); return; }
    hipLaunchKernelGGL(fwd_mega, dim3(grid_blocks), dim3(NTHR), LDS_BYTES, stream, p);
    const hipError_t e = hipPeekAtLastError();
    if (e != hipSuccess) fprintf(stderr, "kernel_launch: launch failed: %s (grid %d)\n", hipGetErrorString(e), grid_blocks);
}
```
